# Optimizing an MI355X kernel written in HIP

```python
import jax, jax.numpy as jnp
from jax import lax
import numpy as np

D_MODEL = 1024
BATCH = 8
SEQ = 8192
DEPTH = 1

HEAD_DIM = 128
N_HEADS_GDN = 4
N_HEADS_FOX = 4
W_GDN = N_HEADS_GDN * HEAD_DIM
W_FOX = N_HEADS_FOX * HEAD_DIM
CONV_WIDTH = 4
CHUNK = 64
Q_BLOCK = 128
EPS = 1e-6
SPLITS = (W_GDN, W_GDN, W_GDN, N_HEADS_GDN, N_HEADS_GDN, W_GDN,
          W_FOX, W_FOX, W_FOX, N_HEADS_FOX, W_FOX,
          D_MODEL, D_MODEL)
D_IN = 4 * W_GDN + 2 * N_HEADS_GDN + 4 * W_FOX + N_HEADS_FOX + 2 * D_MODEL

kernel_name = 'hybrid_gdn_fox_gated_merge_block'


def rmsnorm(x, g):
    xf = x.astype(jnp.float32)
    y = xf * lax.rsqrt(jnp.mean(xf * xf, axis=-1, keepdims=True) + EPS)
    return (y * g.astype(jnp.float32)).astype(x.dtype)


def l2norm(x):
    xf = x.astype(jnp.float32)
    return xf * lax.rsqrt(jnp.sum(xf * xf, axis=-1, keepdims=True) + EPS)


def causal_conv_silu(u, w):
    K = w.shape[0]
    T = u.shape[1]
    up = jnp.pad(u, ((0, 0), (K - 1, 0), (0, 0)))
    y = sum(up[:, i:i + T] * w[i] for i in range(K))
    return jax.nn.silu(y)


def gated_delta_rule(q, k, v, g, beta):
    B, T, H, Dk = q.shape
    Dv = v.shape[-1]
    N = T // CHUNK
    f32 = jnp.float32
    q = q.astype(f32) * (Dk ** -0.5)

    def to_chunks(a):
        a = a.astype(f32).reshape((B, N, CHUNK, H) + a.shape[3:])
        return jnp.swapaxes(a, 2, 3)

    qc, kc, vc = to_chunks(q), to_chunks(k), to_chunks(v)
    gc, bc = to_chunks(g), to_chunks(beta)
    g_cum = jnp.cumsum(gc, axis=-1)
    idx = jnp.arange(CHUNK)
    causal = idx[:, None] >= idx[None, :]
    strict = idx[:, None] > idx[None, :]
    diff = g_cum[..., :, None] - g_cum[..., None, :]
    decay = jnp.where(causal, jnp.exp(jnp.where(causal, diff, 0.0)), 0.0)
    k_beta = kc * bc[..., None]
    v_beta = vc * bc[..., None]
    L = jnp.where(strict, jnp.einsum('bnhcd,bnhsd->bnhcs', k_beta, kc) * decay, 0.0)
    eye = jnp.eye(CHUNK, dtype=f32)
    Tm = lax.linalg.triangular_solve(eye + L, jnp.broadcast_to(eye, L.shape), left_side=True, lower=True)
    u = jnp.einsum('bnhcs,bnhse->bnhce', Tm, v_beta)
    w = jnp.einsum('bnhcs,bnhsd->bnhcd', Tm, k_beta * jnp.exp(g_cum)[..., None])
    qk = jnp.einsum('bnhcd,bnhsd->bnhcs', qc, kc) * decay

    def step(S, inp):
        q_i, k_i, u_i, w_i, qk_i, g_i = inp
        v_new = u_i - jnp.einsum('bhcd,bhde->bhce', w_i, S)
        o = jnp.einsum('bhcd,bhde->bhce', q_i * jnp.exp(g_i)[..., None], S) + jnp.einsum('bhcs,bhse->bhce', qk_i, v_new)
        g_last = g_i[..., -1]
        S = S * jnp.exp(g_last)[..., None, None] + jnp.einsum(
            'bhcd,bhce->bhde', k_i * jnp.exp(g_last[..., None] - g_i)[..., None], v_new)
        return S, o

    xs = tuple(jnp.moveaxis(a, 1, 0) for a in (qc, kc, u, w, qk, g_cum))
    S0 = jnp.zeros((B, H, Dk, Dv), f32)
    _, o = lax.scan(step, S0, xs)
    return o.transpose(1, 0, 3, 2, 4).reshape(B, T, H, Dv)


def forgetting_attention(q, k, v, log_f):
    B, T, H, D = q.shape
    nb = T // Q_BLOCK
    cT = jnp.cumsum(log_f, axis=1).transpose(0, 2, 1)
    qb = q.reshape(B, nb, Q_BLOCK, H, D).transpose(1, 0, 2, 3, 4)
    cb = cT.reshape(B, H, nb, Q_BLOCK).transpose(2, 0, 1, 3)
    kpos = jnp.arange(T)
    scale = D ** -0.5

    def block(args):
        q_i, c_i, i = args
        s = jnp.einsum('bqhd,bkhd->bhqk', q_i, k).astype(jnp.float32) * scale
        s = s + c_i[..., :, None] - cT[:, :, None, :]
        qpos = i * Q_BLOCK + jnp.arange(Q_BLOCK)
        s = jnp.where(qpos[:, None] >= kpos[None, :], s, -jnp.inf)
        p = jax.nn.softmax(s, axis=-1)
        return jnp.einsum('bhqk,bkhd->bqhd', p.astype(v.dtype), v)

    o = lax.map(block, (qb, cb, jnp.arange(nb)))
    return o.transpose(1, 0, 2, 3, 4).reshape(B, T, H, D)


def setup_inputs(seed: int = 0) -> dict:
    key = jax.random.key(seed)
    ks = jax.random.split(key, 18)
    D = D_MODEL
    nrm = jax.random.normal
    x = nrm(ks[0], (BATCH, SEQ, D), jnp.float32)
    c = nrm(ks[1], (BATCH, D), jnp.float32)
    w_ada = 0.1 * nrm(ks[2], (D, 3 * D), jnp.float32) * D ** -0.5
    b_ada = 0.02 * nrm(ks[3], (3 * D,), jnp.float32)
    g_norm = 1.0 + 0.05 * nrm(ks[4], (D,), jnp.float32)
    w_in = nrm(ks[5], (D, D_IN), jnp.float32) * D ** -0.5
    conv_w = nrm(ks[6], (CONV_WIDTH, 3 * W_GDN), jnp.float32) * CONV_WIDTH ** -0.5
    A_log = jnp.log(jax.random.uniform(ks[7], (N_HEADS_GDN,), jnp.float32, 1.0, 16.0))
    dt = jnp.exp(jax.random.uniform(ks[8], (N_HEADS_GDN,), jnp.float32, np.log(1e-3), np.log(1e-1)))
    dt_bias = dt + jnp.log(-jnp.expm1(-dt))
    g_gdn_out = 1.0 + 0.05 * nrm(ks[9], (HEAD_DIM,), jnp.float32)
    g_q_fox = 1.0 + 0.05 * nrm(ks[10], (HEAD_DIM,), jnp.float32)
    g_k_fox = 1.0 + 0.05 * nrm(ks[11], (HEAD_DIM,), jnp.float32)
    b_f = jax.random.uniform(ks[12], (N_HEADS_FOX,), jnp.float32, 1.0, 5.0)
    w_o_gdn = nrm(ks[13], (W_GDN, D), jnp.float32) * W_GDN ** -0.5
    w_o_fox = nrm(ks[14], (W_FOX, D), jnp.float32) * W_FOX ** -0.5
    w_out = nrm(ks[15], (D, D), jnp.float32) * D ** -0.5
    return {'x': x, 'c': c, 'w_ada': w_ada, 'b_ada': b_ada, 'g_norm': g_norm, 'w_in': w_in,
            'conv_w': conv_w, 'A_log': A_log, 'dt_bias': dt_bias, 'g_gdn_out': g_gdn_out,
            'g_q_fox': g_q_fox, 'g_k_fox': g_k_fox, 'b_f': b_f, 'w_o_gdn': w_o_gdn,
            'w_o_fox': w_o_fox, 'w_out': w_out}


def reference(x, c, w_ada, b_ada, g_norm, w_in, conv_w, A_log, dt_bias, g_gdn_out,
              g_q_fox, g_k_fox, b_f, w_o_gdn, w_o_fox, w_out):
    B, T, _ = x.shape
    f32 = jnp.float32
    split_idx = np.cumsum(SPLITS)[:-1].tolist()
    for _layer in range(DEPTH):
        mod = (c @ w_ada + b_ada)[:, None, :]
        shift, scale, gate = jnp.split(mod, 3, axis=-1)
        h = rmsnorm(x, g_norm) * (1.0 + scale) + shift
        proj = h @ w_in
        (qa, ka, va, a_a, b_a, za, qf, kf, vf, f_f, zf, ga, gf) = jnp.split(proj, split_idx, axis=-1)

        qkv = causal_conv_silu(jnp.concatenate([qa, ka, va], axis=-1), conv_w)
        qa, ka, va = jnp.split(qkv, 3, axis=-1)
        qa = l2norm(qa.reshape(B, T, N_HEADS_GDN, HEAD_DIM))
        ka = l2norm(ka.reshape(B, T, N_HEADS_GDN, HEAD_DIM))
        va = va.reshape(B, T, N_HEADS_GDN, HEAD_DIM)
        g_dec = -jnp.exp(A_log.astype(f32)) * jax.nn.softplus(a_a.astype(f32) + dt_bias.astype(f32))
        beta = jax.nn.sigmoid(b_a.astype(f32))
        o_a = gated_delta_rule(qa, ka, va, g_dec, beta).astype(x.dtype)
        o_a = rmsnorm(o_a, g_gdn_out) * jax.nn.silu(za.reshape(B, T, N_HEADS_GDN, HEAD_DIM))
        y_a = o_a.reshape(B, T, W_GDN) @ w_o_gdn

        qf = rmsnorm(qf.reshape(B, T, N_HEADS_FOX, HEAD_DIM), g_q_fox)
        kf = rmsnorm(kf.reshape(B, T, N_HEADS_FOX, HEAD_DIM), g_k_fox)
        vf = vf.reshape(B, T, N_HEADS_FOX, HEAD_DIM)
        log_f = jax.nn.log_sigmoid(f_f.astype(f32) + b_f.astype(f32))
        o_f = forgetting_attention(qf, kf, vf, log_f)
        o_f = o_f * jax.nn.silu(zf.reshape(B, T, N_HEADS_FOX, HEAD_DIM))
        y_f = o_f.reshape(B, T, W_FOX) @ w_o_fox

        merged = jax.nn.sigmoid(ga) * y_a + jax.nn.sigmoid(gf) * y_f
        x = x + gate * (merged @ w_out)
    return x
```

```cpp
#include <hip/hip_runtime.h>
#include <hip/hip_bf16.h>
#include <hip/hip_cooperative_groups.h>
#include <cstdio>
#include <cstdint>
namespace cg = cooperative_groups;
#ifndef REPEAT_PH
#define REPEAT_PH -1
#endif
#ifndef PH_MASK
#define PH_MASK 127
#endif

constexpr int NBATCH = 8, SEQ = 8192, DM = 1024, MTOK = NBATCH * SEQ, NHEAD = 4, HDIM = 128;
constexpr int DIN = 6156, NPROJ = 6144;
constexpr size_t WS_CTRL = 0;
constexpr size_t WS_MOD = 4096;
constexpr size_t WS_WSMALL = WS_MOD + (size_t)NBATCH * 3072 * 4;
constexpr size_t WS_WIN_T = WS_WSMALL + 12 * 1024 * 4;
constexpr size_t WS_WO2_T = WS_WIN_T + (size_t)NPROJ * 1024 * 2;
constexpr size_t WS_WOUT2_T = WS_WO2_T + (size_t)2048 * 512 * 2;
constexpr size_t WS_GDEC = WS_WOUT2_T + (size_t)1024 * 2048 * 2;
constexpr size_t WS_BETA = WS_GDEC + (size_t)MTOK * 16;
constexpr size_t WS_LOGF = WS_BETA + (size_t)MTOK * 16;
constexpr size_t WS_KBIAS = WS_LOGF + (size_t)MTOK * 16;
constexpr size_t WS_HB = WS_KBIAS + (size_t)MTOK * 16;
constexpr size_t WS_GQKV = WS_HB + (size_t)MTOK * 1024 * 2;
constexpr size_t WS_FQKV = WS_GQKV + (size_t)MTOK * 1536 * 2;
constexpr size_t WS_ZG = WS_FQKV + (size_t)3 * MTOK * 512 * 2;
constexpr size_t WS_PREPB = WS_ZG + (size_t)MTOK * 3072 * 2;
constexpr size_t WS_END = WS_PREPB + (size_t)4096 * 8704;
static_assert(WS_WIN_T % 256 == 0 && WS_HB % 256 == 0 && WS_ZG % 256 == 0, "align");

struct Params {
    const float* x; const float* c; const float* w_ada; const float* b_ada; const float* g_norm; const float* w_in;
    const float* conv_w; const float* A_log; const float* dt_bias; const float* g_gdn_out; const float* g_q_fox; const float* g_k_fox;
    const float* b_f; const float* w_o_gdn; const float* w_o_fox; const float* w_out;
    float* out; unsigned char* ws;
};

__device__ __forceinline__ float bf2f(unsigned short u) { return __uint_as_float((unsigned)u << 16); }
typedef __bf16 bf16v2_t __attribute__((ext_vector_type(2)));
typedef float f32v2_t __attribute__((ext_vector_type(2)));
__device__ __forceinline__ unsigned pk_bf16(float lo, float hi) { unsigned r; asm volatile("v_cvt_pk_bf16_f32 %0, %1, %2" : "=v"(r) : "v"(lo), "v"(hi)); return r; }
__device__ __forceinline__ unsigned pk_bf16c(float lo, float hi) { const bf16v2_t r = __builtin_convertvector((f32v2_t){lo, hi}, bf16v2_t); return __builtin_bit_cast(unsigned, r); }
__device__ __forceinline__ float sigmoidf_(float v) { return 1.f / (1.f + __expf(-v)); }
__device__ __forceinline__ float siluf_(float v) { return v / (1.f + __expf(-v)); }
__device__ __forceinline__ float softplusf_(float v) { return fmaxf(v, 0.f) + log1pf(__expf(-fabsf(v))); }
#define WG_BARRIER() do { asm volatile("s_waitcnt vmcnt(0) lgkmcnt(0)" ::: "memory"); __builtin_amdgcn_s_barrier(); asm volatile("" ::: "memory"); } while (0)

namespace pg8 {
#define PG8_LAS __attribute__((address_space(3)))
typedef unsigned short bf16_t;
typedef short bf16x8 __attribute__((ext_vector_type(8)));
typedef float f32x4 __attribute__((ext_vector_type(4)));
typedef unsigned u32x4 __attribute__((ext_vector_type(4)));
constexpr int BM = 256, BK = 64, HALF = 128, HTB = HALF * BK * 2  , STAGE_BYTES = 8 * HTB, NXCD = 8, WGM = 8;

__host__ __device__ __forceinline__ int lds_byte(int r, int c) { const int st = (r >> 4) * 2 + (c >> 5), rr = r & 15, cc = c & 31, ob = rr * 64 + cc * 2; return st * 1024 + (ob ^ (((ob >> 9) & 1) << 5)); }
__host__ __device__ __forceinline__ void stage_rc(int b, int& R, int& C) { const int st = b / 1024, sb = b % 1024, swz = sb ^ (((sb >> 9) & 1) << 5); R = (st >> 1) * 16 + swz / 64; C = (st & 1) * 32 + (swz % 64) / 2; }
__host__ __device__ __forceinline__ int perm32(int rho) { const int n = rho >> 4, i = rho & 15; return 8 * (i >> 2) + 4 * n + (i & 3); }

struct Unit { int pm, pn; };
struct Gemm { const bf16_t* A; const bf16_t* Bt; int M, N, K, lda, ldb; };

struct StaticOrder {
    int nM, nN, nwg, G, c;
    __host__ __device__ void init(int M, int N, int G_, int c_) { nM = M / BM; nN = N / BM; nwg = nM * nN; G = G_; c = c_; }
    __host__ __device__ bool next(int i, Unit& u) const {
        const long L = (long)i * G + c; if (L >= nwg) return false;
        int wgid = (int)L; { const int q = nwg / NXCD, r = nwg % NXCD, xcd = wgid % NXCD, off = wgid / NXCD; wgid = (xcd < r ? xcd * (q + 1) : r * (q + 1) + (xcd - r) * q) + off; }
        const int nig = WGM * nN, gid = wgid / nig, fm = gid * WGM, gsz = (nM - fm) < WGM ? (nM - fm) : WGM;
        u.pm = fm + ((wgid % nig) % gsz); u.pn = (wgid % nig) / gsz; return true;
    }
    __device__ __forceinline__ void a_ready(const Unit&) const {}
    __device__ __forceinline__ void done(const Unit&) const {}
};

typedef unsigned u32x4 __attribute__((ext_vector_type(4)));
__device__ __forceinline__ u32x4 pack8bf(const f32x4 v0, const f32x4 v1) { u32x4 w; w.x = pk_bf16(v0[0], v0[1]); w.y = pk_bf16(v0[2], v0[3]); w.z = pk_bf16(v1[0], v1[1]); w.w = pk_bf16(v1[2], v1[3]); return w; }
struct EpiProj {
    static constexpr bool PERM = true, AFTER_DRAIN = false, MIDHOOK = false;
    bf16_t* gqkv; bf16_t* fqkv; bf16_t* zg; const float* gq; const float* gk; PG8_LAS float* X;
    __device__ __forceinline__ void operator()(const f32x4 (&acc)[2][2][4][2], const Unit& u, int wr, int wc, int fr, int fq) const {
        const int pn = u.pn, row0 = u.pm * BM + wr * 64 + fr, cl = wc * 32 + 8 * fq;
        const bool nrm = pn >= 8 && pn < 12;
        if (nrm) {
#pragma unroll
            for (int ai = 0; ai < 2; ++ai)
#pragma unroll
                for (int m = 0; m < 4; ++m)
#pragma unroll
                    for (int bj = 0; bj < 2; ++bj) { const f32x4 a = acc[ai][bj][m][0], b = acc[ai][bj][m][1];
                        float s = (a[0] * a[0] + a[1] * a[1]) + (a[2] * a[2] + a[3] * a[3]) + (b[0] * b[0] + b[1] * b[1]) + (b[2] * b[2] + b[3] * b[3]);
                        s += __shfl_xor(s, 16); s += __shfl_xor(s, 32);
                        if (fq == 0) X[((ai * HALF + wr * 64 + m * 16 + fr) * 2 + bj) * 4 + wc] = s; asm volatile("" ::: "memory"); }
            asm volatile("s_waitcnt lgkmcnt(0)" ::: "memory"); __builtin_amdgcn_s_barrier(); asm volatile("" ::: "memory");
        }
        bf16_t* base; size_t bstride, bjstride; int ld;
        if (pn >= 8 && pn < 14) { base = fqkv + (size_t)((pn - 8) >> 1) * ((size_t)MTOK * 512) + (size_t)((pn & 1) * 2) * SEQ * 128 + cl; bstride = (size_t)4 * SEQ * 128; bjstride = (size_t)SEQ * 128; ld = 128; }
        else if (pn < 6) { base = gqkv + pn * 256 + cl; bstride = (size_t)SEQ * 1536; bjstride = 128; ld = 1536; }
        else { const int c0 = pn < 8 ? (pn - 6) * 256 : (pn < 16 ? 512 + (pn - 14) * 256 : 1024 + (pn - 16) * 256); base = zg + c0 + cl; bstride = (size_t)SEQ * 3072; bjstride = 128; ld = 3072; }
        const float* gv = (pn < 10) ? gq : gk;
        base += (size_t)((u.pm * BM) >> 13) * bstride;
        const int t0 = (row0 & 8191);
#pragma unroll
        for (int ai = 0; ai < 2; ++ai)
#pragma unroll
            for (int m = 0; m < 4; ++m) { bf16_t* rowp = base + (size_t)(t0 + ai * HALF + m * 16) * ld;
#pragma unroll
                for (int bj = 0; bj < 2; ++bj) { float r = 1.f; f32x4 g0 = {1.f, 1.f, 1.f, 1.f}, g1 = {1.f, 1.f, 1.f, 1.f};
                    if (nrm) { g0 = *(const f32x4*)(gv + cl); g1 = *(const f32x4*)(gv + cl + 4); const f32x4 t4 = *(const PG8_LAS f32x4*)(X + ((ai * HALF + wr * 64 + m * 16 + fr) * 2 + bj) * 4); r = 1.0f / sqrtf(((t4[0] + t4[1]) + (t4[2] + t4[3])) * (1.0f / 128.0f) + 1e-6f); }
                    *(u32x4*)(rowp + bj * bjstride) = pack8bf(acc[ai][bj][m][0] * (g0 * r), acc[ai][bj][m][1] * (g1 * r)); }
                asm volatile("" ::: "memory"); }
    }
};
struct EpiGate {
    static constexpr bool PERM = true, AFTER_DRAIN = false, MIDHOOK = false;
    bf16_t* G; const bf16_t* gate; int add;
    __device__ __forceinline__ void operator()(const f32x4 (&acc)[2][2][4][2], const Unit& u, int wr, int wc, int fr, int fq) const {
        const int row0 = u.pm * BM + wr * 64 + fr, col0 = u.pn * BM + wc * 32 + 8 * fq;
#pragma unroll
        for (int ai = 0; ai < 2; ++ai)
#pragma unroll
            for (int m = 0; m < 4; ++m) { const size_t gr = (size_t)(row0 + ai * HALF + m * 16);
#pragma unroll
                for (int bj = 0; bj < 2; ++bj) { const u32x4 gw = *(const u32x4*)(gate + gr * 3072 + col0 + bj * HALF);
                    f32x4 s0, s1;
                    s0[0] = __uint_as_float(gw.x << 16); s0[1] = __uint_as_float(gw.x & 0xffff0000u); s0[2] = __uint_as_float(gw.y << 16); s0[3] = __uint_as_float(gw.y & 0xffff0000u);
                    s1[0] = __uint_as_float(gw.z << 16); s1[1] = __uint_as_float(gw.z & 0xffff0000u); s1[2] = __uint_as_float(gw.w << 16); s1[3] = __uint_as_float(gw.w & 0xffff0000u);
#pragma unroll
                    for (int i = 0; i < 4; ++i) { s0[i] = __builtin_amdgcn_rcpf(1.f + __builtin_amdgcn_exp2f(-1.4426950408889634f * s0[i])); s1[i] = __builtin_amdgcn_rcpf(1.f + __builtin_amdgcn_exp2f(-1.4426950408889634f * s1[i])); }
                    f32x4 v0 = acc[ai][bj][m][0] * s0, v1 = acc[ai][bj][m][1] * s1;
                    bf16_t* dst = G + gr * 1024 + col0 + bj * HALF;
                    if (add) { const u32x4 pw = *(const u32x4*)dst;
                        v0[0] += __uint_as_float(pw.x << 16); v0[1] += __uint_as_float(pw.x & 0xffff0000u); v0[2] += __uint_as_float(pw.y << 16); v0[3] += __uint_as_float(pw.y & 0xffff0000u);
                        v1[0] += __uint_as_float(pw.z << 16); v1[1] += __uint_as_float(pw.z & 0xffff0000u); v1[2] += __uint_as_float(pw.w << 16); v1[3] += __uint_as_float(pw.w & 0xffff0000u); }
                    *(u32x4*)dst = pack8bf(v0, v1); }
                if (m == 3) asm volatile("" ::: "memory"); }
    }
};
struct EpiMerge {
    static constexpr bool PERM = true, AFTER_DRAIN = false, MIDHOOK = true;
    bf16_t* G; const bf16_t* gate;
    __device__ __forceinline__ static void unpack8(const u32x4 gw, f32x4& s0, f32x4& s1) {
        s0[0] = __uint_as_float(gw.x << 16); s0[1] = __uint_as_float(gw.x & 0xffff0000u); s0[2] = __uint_as_float(gw.y << 16); s0[3] = __uint_as_float(gw.y & 0xffff0000u);
        s1[0] = __uint_as_float(gw.z << 16); s1[1] = __uint_as_float(gw.z & 0xffff0000u); s1[2] = __uint_as_float(gw.w << 16); s1[3] = __uint_as_float(gw.w & 0xffff0000u); }
    __device__ __forceinline__ void mid(f32x4 (&acc)[2][2][4][2], const Unit& u, int wr, int wc, int fr, int fq) const {
        const bf16_t* gp = gate + (size_t)(u.pm * BM + wr * 64 + fr) * 3072 + (u.pn * BM + wc * 32 + 8 * fq);
        asm volatile("" : "+v"(gp));
#pragma unroll
        for (int ai = 0; ai < 2; ++ai)
#pragma unroll
            for (int m = 0; m < 4; ++m) { const bf16_t* rp = gp + (size_t)(ai * HALF + m * 16) * 3072;
#pragma unroll
                for (int bj = 0; bj < 2; ++bj) { f32x4 a0, a1, f0, f1;
                    unpack8(*(const u32x4*)(rp + bj * HALF), a0, a1); unpack8(*(const u32x4*)(rp + 1024 + bj * HALF), f0, f1);
#pragma unroll
                    for (int i = 0; i < 4; ++i) {
                        a0[i] = (1.f + __builtin_amdgcn_exp2f(-1.4426950408889634f * f0[i])) * __builtin_amdgcn_rcpf(1.f + __builtin_amdgcn_exp2f(-1.4426950408889634f * a0[i]));
                        a1[i] = (1.f + __builtin_amdgcn_exp2f(-1.4426950408889634f * f1[i])) * __builtin_amdgcn_rcpf(1.f + __builtin_amdgcn_exp2f(-1.4426950408889634f * a1[i])); }
                    acc[ai][bj][m][0] *= a0; acc[ai][bj][m][1] *= a1; }
                asm volatile("" ::: "memory"); }
    }
    __device__ __forceinline__ void operator()(const f32x4 (&acc)[2][2][4][2], const Unit& u, int wr, int wc, int fr, int fq) const {
        const int row0 = u.pm * BM + wr * 64 + fr, col0 = u.pn * BM + wc * 32 + 8 * fq;
#pragma unroll
        for (int ai = 0; ai < 2; ++ai)
#pragma unroll
            for (int m = 0; m < 4; ++m) { const size_t gr = (size_t)(row0 + ai * HALF + m * 16);
#pragma unroll
                for (int bj = 0; bj < 2; ++bj) { f32x4 s0, s1; unpack8(*(const u32x4*)(gate + gr * 3072 + 1024 + col0 + bj * HALF), s0, s1);
#pragma unroll
                    for (int i = 0; i < 4; ++i) { s0[i] = __builtin_amdgcn_rcpf(1.f + __builtin_amdgcn_exp2f(-1.4426950408889634f * s0[i])); s1[i] = __builtin_amdgcn_rcpf(1.f + __builtin_amdgcn_exp2f(-1.4426950408889634f * s1[i])); }
                    *(u32x4*)(G + gr * 1024 + col0 + bj * HALF) = pack8bf(acc[ai][bj][m][0] * s0, acc[ai][bj][m][1] * s1); }
                if (m & 1) asm volatile("" ::: "memory"); }
    }
};
struct EpiOut {
    static constexpr bool PERM = true, AFTER_DRAIN = false, MIDHOOK = false;
    const float* x; float* out; const float* mod;
    __device__ __forceinline__ void operator()(const f32x4 (&acc)[2][2][4][2], const Unit& u, int wr, int wc, int fr, int fq) const {
        const int row0 = u.pm * BM + wr * 64 + fr, col0 = u.pn * BM + wc * 32 + 8 * fq;
        const float* gp = mod + (size_t)((u.pm * BM) >> 13) * 3072 + 2048 + col0;
        f32x4 gt[2][2];
#pragma unroll
        for (int bj = 0; bj < 2; ++bj) { gt[bj][0] = *(const f32x4*)(gp + bj * HALF); gt[bj][1] = *(const f32x4*)(gp + bj * HALF + 4); }
#pragma unroll
        for (int ai = 0; ai < 2; ++ai)
#pragma unroll
            for (int m = 0; m < 4; ++m) { const size_t off = (size_t)(row0 + ai * HALF + m * 16) * DM + col0;
#pragma unroll
                for (int bj = 0; bj < 2; ++bj) { const f32x4 x0 = *(const f32x4*)(x + off + bj * HALF), x1 = *(const f32x4*)(x + off + bj * HALF + 4);
                    *(f32x4*)(out + off + bj * HALF) = x0 + gt[bj][0] * acc[ai][bj][m][0]; *(f32x4*)(out + off + bj * HALF + 4) = x1 + gt[bj][1] * acc[ai][bj][m][1]; } }
    }
};

template <class Epi, class Sched, bool ALIGN_EPI = false, bool SP2 = false>
__device__ __forceinline__ void gemm_phase(PG8_LAS unsigned char* lds, const Gemm g, const Sched& S, const Epi& E) {
    const int tid = threadIdx.x, wid = __builtin_amdgcn_readfirstlane(tid >> 6), lane = tid & 63, wr = wid >> 2, wc = wid & 3, fr = lane & 15, fq = lane >> 4;
    const int K = g.K, nt = K / BK;
    unsigned voffA[2], voffB[2];
#pragma unroll
    for (int i = 0; i < 2; ++i) { int R, C; stage_rc(tid * 16 + i * 8192, R, C); const int Rb = Epi::PERM ? ((R & ~31) + perm32(R & 31)) : R;
        voffA[i] = (unsigned)(R * g.lda + C) * 2u; voffB[i] = (unsigned)(Rb * g.ldb + C) * 2u; }
    const size_t kstep = (size_t)(BK * 2);
    const size_t hstepA = (size_t)HALF * g.lda * 2, hstepB = (size_t)HALF * g.ldb * 2;
    const size_t tstepA = 2 * hstepA, tstepB = 2 * hstepB;
    const unsigned ldsw = (unsigned)wid * 1024u;
    const int aoff = lds_byte(wr * 64 + fr, fq * 8), boff = lds_byte(wc * 32 + fr, fq * 8);
#define PG8_SA(b, h) (((b) * 2 + (h)) * HTB)
#define PG8_SB(b, h) ((4 + (b) * 2 + (h)) * HTB)
#define PG8_STAGE(bufoff, gbase, voff) do { _Pragma("unroll") for (int _i = 0; _i < 2; ++_i) \
        __builtin_amdgcn_global_load_lds((const unsigned*)((const char*)(gbase) + (voff)[_i]), (PG8_LAS unsigned*)(lds + (bufoff) + ldsw + _i * 8192), 16, 0, 0); } while (0)
#define PG8_LDA(dst, b, h) do { _Pragma("unroll") for (int m = 0; m < 4; ++m) _Pragma("unroll") for (int k = 0; k < 2; ++k) dst[m][k] = *(const PG8_LAS bf16x8*)(lds + PG8_SA(b, h) + aoff + m * 2048 + k * 1024); } while (0)
#define PG8_LDB(dst, b, h) do { _Pragma("unroll") for (int n = 0; n < 2; ++n) _Pragma("unroll") for (int k = 0; k < 2; ++k) dst[n][k] = *(const PG8_LAS bf16x8*)(lds + PG8_SB(b, h) + boff + n * 2048 + k * 1024); } while (0)
#define PG8_MMA(ai, bj, At, Bt) do { __builtin_amdgcn_s_setprio(1); _Pragma("unroll") for (int m = 0; m < 4; ++m) _Pragma("unroll") for (int n = 0; n < 2; ++n) _Pragma("unroll") for (int k = 0; k < 2; ++k) \
        acc[ai][bj][m][n] = __builtin_amdgcn_mfma_f32_16x16x32_bf16(Bt[n][k], At[m][k], acc[ai][bj][m][n], 0, 0, 0); __builtin_amdgcn_s_setprio(0); } while (0)
#define PG8_WAIT_V(n) asm volatile("s_waitcnt vmcnt(" #n ")" ::: "memory")
#define PG8_WAIT_L(n) asm volatile("s_waitcnt lgkmcnt(" #n ")" ::: "memory")
#define PG8_BAR __builtin_amdgcn_s_barrier()
#define PG8_SCHED __builtin_amdgcn_sched_barrier(0)
    Unit cur, nxt; int ui = 0;
    if (!S.next(0, cur)) return;
    f32x4 acc[2][2][4][2];
#pragma unroll
    for (int a = 0; a < 2; ++a)
#pragma unroll
        for (int b = 0; b < 2; ++b)
#pragma unroll
            for (int m = 0; m < 4; ++m)
#pragma unroll
                for (int n = 0; n < 2; ++n) acc[a][b][m][n] = (f32x4){0.f, 0.f, 0.f, 0.f};
    bf16x8 At[4][2], B0[2][2], B1[2][2];
    const char* cA = (const char*)g.A + (size_t)cur.pm * tstepA; const char* cB = (const char*)g.Bt + (size_t)cur.pn * tstepB;
    S.a_ready(cur);
    if constexpr (SP2) {
        PG8_STAGE(PG8_SB(0, 0), cB, voffB); PG8_STAGE(PG8_SB(0, 1), cB + hstepB, voffB); PG8_STAGE(PG8_SA(0, 0), cA, voffA); PG8_STAGE(PG8_SA(0, 1), cA + hstepA, voffA);
        if (wr == 1) PG8_BAR;
        PG8_WAIT_V(2); PG8_BAR;
        PG8_STAGE(PG8_SB(1, 0), cB + kstep, voffB); PG8_STAGE(PG8_SA(1, 0), cA + kstep, voffA); PG8_STAGE(PG8_SB(1, 1), cB + hstepB + kstep, voffB);
        PG8_WAIT_V(6); PG8_BAR;
    } else {
        PG8_STAGE(PG8_SB(0, 0), cB, voffB); PG8_STAGE(PG8_SA(0, 0), cA, voffA); PG8_STAGE(PG8_SB(0, 1), cB + hstepB, voffB); PG8_STAGE(PG8_SA(0, 1), cA + hstepA, voffA);
        if (wr == 1) PG8_BAR;
        PG8_WAIT_V(4); PG8_BAR;
        PG8_STAGE(PG8_SB(1, 0), cB + kstep, voffB); PG8_STAGE(PG8_SA(1, 0), cA + kstep, voffA); PG8_STAGE(PG8_SB(1, 1), cB + hstepB + kstep, voffB);
        PG8_WAIT_V(6); PG8_BAR;
    }
    for (;;) {
        const bool has_next = S.next(ui + 1, nxt);
        const char* nA = has_next ? (const char*)g.A + (size_t)nxt.pm * tstepA : cA; const char* nB = has_next ? (const char*)g.Bt + (size_t)nxt.pn * tstepB : cB;
        for (int t = 0; t < nt; t += 2) {
            if constexpr (Epi::MIDHOOK) { if (t == (nt >> 1)) E.mid(acc, cur, wr, wc, fr, fq); }
            const bool last = (t == nt - 2);
            const char* a1 = cA + (size_t)(t + 1) * kstep;
            const char* a2 = last ? nA : cA + (size_t)(t + 2) * kstep; const char* b2 = last ? nB : cB + (size_t)(t + 2) * kstep;
            const char* a3 = a2 + kstep; const char* b3 = b2 + kstep;
            if (last && has_next) S.a_ready(nxt);
            if constexpr (SP2) {
            PG8_LDB(B0, 0, 0); PG8_LDB(B1, 0, 1); PG8_SCHED; PG8_LDA(At, 0, 0); PG8_STAGE(PG8_SA(1, 1), a1 + hstepA, voffA);
            PG8_WAIT_V(8); PG8_WAIT_L(0); PG8_BAR; PG8_MMA(0, 0, At, B0); PG8_MMA(0, 1, At, B1); PG8_BAR; PG8_SCHED;
            PG8_LDA(At, 0, 1); PG8_STAGE(PG8_SB(0, 0), b2, voffB); PG8_STAGE(PG8_SB(0, 1), b2 + hstepB, voffB); PG8_STAGE(PG8_SA(0, 0), a2, voffA);
            PG8_WAIT_V(8); PG8_WAIT_L(0); PG8_BAR; PG8_MMA(1, 0, At, B0); PG8_MMA(1, 1, At, B1); PG8_BAR; PG8_SCHED;
            PG8_LDB(B0, 1, 0); PG8_LDB(B1, 1, 1); PG8_SCHED; PG8_LDA(At, 1, 0); PG8_STAGE(PG8_SA(0, 1), a2 + hstepA, voffA);
            PG8_WAIT_V(8); PG8_WAIT_L(0); PG8_BAR; PG8_MMA(0, 0, At, B0); PG8_MMA(0, 1, At, B1); PG8_BAR; PG8_SCHED;
            PG8_LDA(At, 1, 1); PG8_STAGE(PG8_SB(1, 0), b3, voffB); PG8_STAGE(PG8_SB(1, 1), b3 + hstepB, voffB); PG8_STAGE(PG8_SA(1, 0), a3, voffA);
            PG8_WAIT_V(8); PG8_WAIT_L(0); PG8_BAR; PG8_MMA(1, 0, At, B0); PG8_MMA(1, 1, At, B1); PG8_BAR; PG8_SCHED;
            } else {
            PG8_LDB(B0, 0, 0); PG8_SCHED; PG8_LDA(At, 0, 0); PG8_STAGE(PG8_SA(1, 1), a1 + hstepA, voffA);
            PG8_WAIT_L(8); PG8_BAR; PG8_WAIT_L(0); PG8_MMA(0, 0, At, B0); PG8_BAR; PG8_SCHED;
            PG8_LDB(B1, 0, 1); PG8_STAGE(PG8_SB(0, 0), b2, voffB);
            PG8_BAR; PG8_WAIT_L(0); PG8_MMA(0, 1, At, B1); PG8_BAR;
            PG8_LDA(At, 0, 1); PG8_STAGE(PG8_SA(0, 0), a2, voffA);
            PG8_BAR; PG8_WAIT_L(0); PG8_MMA(1, 0, At, B0); PG8_BAR; PG8_SCHED;
            PG8_STAGE(PG8_SB(0, 1), b2 + hstepB, voffB);
            PG8_WAIT_V(6); PG8_BAR; PG8_MMA(1, 1, At, B1); PG8_BAR;
            PG8_LDB(B0, 1, 0); PG8_SCHED; PG8_LDA(At, 1, 0); PG8_STAGE(PG8_SA(0, 1), a2 + hstepA, voffA);
            PG8_WAIT_L(8); PG8_BAR; PG8_WAIT_L(0); PG8_MMA(0, 0, At, B0); PG8_BAR; PG8_SCHED;
            PG8_LDB(B1, 1, 1); PG8_STAGE(PG8_SB(1, 0), b3, voffB);
            PG8_BAR; PG8_WAIT_L(0); PG8_MMA(0, 1, At, B1); PG8_BAR;
            PG8_LDA(At, 1, 1); PG8_STAGE(PG8_SA(1, 0), a3, voffA);
            PG8_BAR; PG8_WAIT_L(0); PG8_MMA(1, 0, At, B0); PG8_BAR; PG8_SCHED;
            PG8_STAGE(PG8_SB(1, 1), b3 + hstepB, voffB);
            PG8_WAIT_V(6); PG8_BAR; PG8_MMA(1, 1, At, B1); PG8_BAR;
            }
        }
        if constexpr (ALIGN_EPI) { if (wr == 0) PG8_BAR; }
        if constexpr (!Epi::AFTER_DRAIN) { E(acc, cur, wr, wc, fr, fq); S.done(cur); }
        if (!has_next) break;
#pragma unroll
        for (int a = 0; a < 2; ++a)
#pragma unroll
            for (int b = 0; b < 2; ++b)
#pragma unroll
                for (int m = 0; m < 4; ++m)
#pragma unroll
                    for (int n = 0; n < 2; ++n) acc[a][b][m][n] = (f32x4){0.f, 0.f, 0.f, 0.f};
        cur = nxt; cA = nA; cB = nB; ++ui;
        if constexpr (ALIGN_EPI) { if (wr == 1) PG8_BAR; }
    }
    PG8_WAIT_V(0);
    if constexpr (!ALIGN_EPI) { if (wr == 0) PG8_BAR; }
    PG8_BAR;
    if constexpr (Epi::AFTER_DRAIN) { E.fused(acc, cur, wr, wc, fr, fq, lds, wid, lane); S.done(cur); }
#undef PG8_SA
#undef PG8_SB
#undef PG8_STAGE
#undef PG8_LDA
#undef PG8_LDB
#undef PG8_MMA
#undef PG8_WAIT_V
#undef PG8_WAIT_L
#undef PG8_BAR
#undef PG8_SCHED
}
}

namespace fox {
constexpr int D = 128; constexpr float THR = 24.f; constexpr bool WSKIP = false; constexpr int OSTR = 1024, ZSTR = 3072;
constexpr float SCALE = 0.08838834764831845f;
constexpr int NW = 8, QBLK = 32, KVBLK = 64, QB = NW * QBLK;
constexpr int SHM_V = KVBLK * D * 2, SHM_K = KVBLK * D * 2;
constexpr int BIAS_OFF = 2 * SHM_V + 2 * SHM_K + NW * 64 * 4, SLOT_OFF = BIAS_OFF + 512, LDS_BYTES = SLOT_OFF + 64;

using bf16 = __hip_bfloat16;
typedef short bf16x8 __attribute__((ext_vector_type(8)));
typedef short s16x4 __attribute__((ext_vector_type(4)));
typedef float f32x16 __attribute__((ext_vector_type(16)));
typedef float f32x4 __attribute__((ext_vector_type(4)));
typedef unsigned u32x4 __attribute__((ext_vector_type(4)));
template <class A, class Bt> struct same_t { static constexpr bool v = false; };
template <class A> struct same_t<A, A> { static constexpr bool v = true; };

#define KSWZ(row, colB) ((row) * 256 + ((colB) ^ (((row) & 7) << 4)))
#define SBAR() __builtin_amdgcn_sched_barrier(0)
__device__ __forceinline__ int v_st(int k, int c) { const int kk = (k & ~0xC) | ((k & 4) << 1) | ((k & 8) >> 1); return ((kk >> 3) * 4 + (c >> 5)) * 512 + ((kk & 7) * 32 + (c & 31)) * 2; }
__device__ __forceinline__ int v_rd_base(int lane) { return ((lane & 3) << 3) | (((lane >> 2) & 3) << 6) | (((lane >> 4) & 1) << 5) | (((lane >> 5) & 1) << 8); }
constexpr int v_rd_off(int d0, int ks, int half) { return d0 * 512 + ks * 4096 + half * 2048; }
__device__ __forceinline__ int crow(int r, int hi) { return (r & 3) + 8 * (r >> 2) + 4 * hi; }
__device__ __forceinline__ unsigned cvtpk(float lo, float hi) {
    unsigned r; asm volatile("v_cvt_pk_bf16_f32 %0, %1, %2" : "=v"(r) : "v"(lo), "v"(hi)); return r;
}
__device__ __forceinline__ bf16x8 pack8(f32x4 a, f32x4 b) {
    u32x4 w = {cvtpk(a[0], a[1]), cvtpk(a[2], a[3]), cvtpk(b[0], b[1]), cvtpk(b[2], b[3])};
    return *reinterpret_cast<bf16x8*>(&w);
}
template <class T> __device__ __forceinline__ bf16x8 load8(const T* p) {
    if constexpr (same_t<T, float>::v) { return pack8(*(const f32x4*)p, *(const f32x4*)(p + 4)); }
    else { return *reinterpret_cast<const bf16x8*>(p); }
}
__device__ __forceinline__ void mask_tile(f32x16& p0, f32x16& p1, int dq, unsigned W) {
    const float NEG = -__builtin_inff();
#pragma unroll
    for (int r = 0; r < 16; ++r) {
        const int c = (r & 3) + 8 * (r >> 2);
        if ((unsigned)(dq - c) >= W) p0[r] = NEG;
        if ((unsigned)(dq - c - 32) >= W) p1[r] = NEG;
    }
}
__device__ __forceinline__ void partialSM(f32x16& p0, f32x16& p1, float& m_reg, float& mn, float& alpha) {
    float pmax = p0[0]; for (int r = 1; r < 16; ++r) pmax = fmaxf(pmax, p0[r]); for (int r = 0; r < 16; ++r) pmax = fmaxf(pmax, p1[r]);
    { auto rr = __builtin_amdgcn_permlane32_swap(__float_as_uint(pmax), __float_as_uint(pmax), false, false);
      pmax = fmaxf(__uint_as_float(rr[0]), __uint_as_float(rr[1])); }
    constexpr float C2 = 1.4426950408889634f * SCALE;
    if (__builtin_expect(__all((pmax - m_reg) * SCALE <= THR), 1)) { mn = m_reg; alpha = 1.f; }
    else { mn = fmaxf(m_reg, pmax); alpha = __builtin_amdgcn_exp2f((m_reg - mn) * C2); m_reg = mn; }
    const float mnL = -mn * C2;
    for (int r = 0; r < 16; ++r) p0[r] = fmaf(p0[r], C2, mnL); for (int r = 0; r < 16; ++r) p1[r] = fmaf(p1[r], C2, mnL);
    for (int r = 0; r < 16; ++r) p0[r] = __builtin_amdgcn_exp2f(p0[r]);
}
__device__ __forceinline__ void finishSM(f32x16& p0, f32x16& p1, float alpha, float& l_reg, bf16x8& pa0, bf16x8& pa1, bf16x8& pa2, bf16x8& pa3) {
    for (int r = 0; r < 16; ++r) p1[r] = __builtin_amdgcn_exp2f(p1[r]);
    float ps = 0; for (int r = 0; r < 16; ++r) ps += p0[r]; for (int r = 0; r < 16; ++r) ps += p1[r];
    { auto rr = __builtin_amdgcn_permlane32_swap(__float_as_uint(ps), __float_as_uint(ps), false, false);
      ps = __uint_as_float(rr[0]) + __uint_as_float(rr[1]); }
    l_reg = l_reg * alpha + ps;
#define PK4(P, B_, OUT) do { unsigned a0 = cvtpk(P[B_+0], P[B_+1]), a1 = cvtpk(P[B_+2], P[B_+3]);                          \
        unsigned b0 = cvtpk(P[B_+4], P[B_+5]), b1 = cvtpk(P[B_+6], P[B_+7]);                                             \
        auto r0 = __builtin_amdgcn_permlane32_swap(a0, b0, false, false); auto r1 = __builtin_amdgcn_permlane32_swap(a1, b1, false, false); \
        u32x4 w = {r0[0], r1[0], r0[1], r1[1]}; OUT = *reinterpret_cast<bf16x8*>(&w); } while (0)
    PK4(p0, 0, pa0); PK4(p0, 8, pa1); PK4(p1, 0, pa2); PK4(p1, 8, pa3);
#undef PK4
}
template <int KB, bool SK>
__device__ __forceinline__ void qkt(f32x16& p0, f32x16& p1, const char* K_lds, int r32, int hi, const bf16x8* qr, bool act) {
    if (SK && !act) { const float NEG = -__builtin_inff();
#pragma unroll
        for (int r = 0; r < 16; ++r) { p0[r] = NEG; p1[r] = NEG; } return; }
    { const char* bb = K_lds + 2 * SHM_K + NW * 64 * 4 + KB * 256 + hi * 16;
      const f32x4 b0 = *(const f32x4*)(bb), b1 = *(const f32x4*)(bb + 32), b2 = *(const f32x4*)(bb + 64), b3 = *(const f32x4*)(bb + 96);
      const f32x4 c0 = *(const f32x4*)(bb + 128), c1 = *(const f32x4*)(bb + 160), c2 = *(const f32x4*)(bb + 192), c3 = *(const f32x4*)(bb + 224);
      p0 = (f32x16){b0[0], b0[1], b0[2], b0[3], b1[0], b1[1], b1[2], b1[3], b2[0], b2[1], b2[2], b2[3], b3[0], b3[1], b3[2], b3[3]};
      p1 = (f32x16){c0[0], c0[1], c0[2], c0[3], c1[0], c1[1], c1[2], c1[3], c2[0], c2[1], c2[2], c2[3], c3[0], c3[1], c3[2], c3[3]}; }
    const char* kb[4];
#pragma unroll
    for (int dd = 0; dd < 4; ++dd) kb[dd] = K_lds + KB * SHM_K + KSWZ(r32, (dd * 16 + hi * 8) * 2);
#pragma unroll
    for (int d0 = 0; d0 < 8; ++d0) { const char* a = kb[d0 & 3] + (d0 >> 2) * 128;
        bf16x8 b0 = *reinterpret_cast<const bf16x8*>(a);
        bf16x8 b1 = *reinterpret_cast<const bf16x8*>(a + 32 * 256);
        p0 = __builtin_amdgcn_mfma_f32_32x32x16_bf16(b0, qr[d0], p0, 0, 0, 0);
        p1 = __builtin_amdgcn_mfma_f32_32x32x16_bf16(b1, qr[d0], p1, 0, 0, 0); }
}
template <int VB, bool SK>
__device__ __forceinline__ void pv_tile(f32x16* o, int vb0, bf16x8 pa0, bf16x8 pa1, bf16x8 pa2, bf16x8 pa3, bool act) {
    if (SK && !act) return;
#define TRRD(dst, off) asm volatile("ds_read_b64_tr_b16 %0, %1 offset:%2" : "=&v"(dst) : "v"(vb0), "i"(off) : "memory")
#define PV_D0(d0) do { s16x4 l0, l1, l2, l3, h0, h1, h2, h3; constexpr int b_ = VB * SHM_V + v_rd_off(d0, 0, 0);     \
        TRRD(l0, b_); TRRD(h0, b_ + 2048); TRRD(l1, b_ + 4096); TRRD(h1, b_ + 6144); TRRD(l2, b_ + 8192); TRRD(h2, b_ + 10240); TRRD(l3, b_ + 12288); TRRD(h3, b_ + 14336); \
        asm volatile("s_waitcnt lgkmcnt(0)" ::: "memory"); SBAR();                 \
        o[d0] = __builtin_amdgcn_mfma_f32_32x32x16_bf16(pa0, (bf16x8){l0[0], l0[1], l0[2], l0[3], h0[0], h0[1], h0[2], h0[3]}, o[d0], 0, 0, 0);   \
        o[d0] = __builtin_amdgcn_mfma_f32_32x32x16_bf16(pa1, (bf16x8){l1[0], l1[1], l1[2], l1[3], h1[0], h1[1], h1[2], h1[3]}, o[d0], 0, 0, 0);   \
        o[d0] = __builtin_amdgcn_mfma_f32_32x32x16_bf16(pa2, (bf16x8){l2[0], l2[1], l2[2], l2[3], h2[0], h2[1], h2[2], h2[3]}, o[d0], 0, 0, 0);   \
        o[d0] = __builtin_amdgcn_mfma_f32_32x32x16_bf16(pa3, (bf16x8){l3[0], l3[1], l3[2], l3[3], h3[0], h3[1], h3[2], h3[3]}, o[d0], 0, 0, 0); } while (0)
    PV_D0(0); PV_D0(1); PV_D0(2); PV_D0(3);
#undef PV_D0
#undef TRRD
}

template <class TIn, class TOut> struct BlockRef { const TIn* Q; const TIn* K; const TIn* V; TOut* O; const float* KB; const unsigned short* Z; int P0; };
template <class TIn> struct Seam {
    bf16x8 qr[8];
    bf16x8 st_v0, st_v1, st_k0, st_k1; float st_b; f32x4 sf0, sf1, sf2, sf3;
    f32x4 tq[16];
};
__device__ __forceinline__ int swa_jlo(int P0, int W) { const int lowk = P0 - W + 1; return lowk > 0 ? lowk / KVBLK : 0; }
#define ROW(p, k0, rr) ((p) + (size_t)((k0) + (rr)) * D + sc)
#define VMW() asm volatile("s_waitcnt vmcnt(0)" ::: "memory")
#define VMWN(n) asm volatile("s_waitcnt vmcnt(%0)" :: "i"(n) : "memory")
#define SLOAD_H(Kp, Vp, Bp, k0) do { S.st_v0 = load8<TIn>(ROW(Vp, k0, sr)); S.st_v1 = load8<TIn>(ROW(Vp, k0, 32 + sr)); S.st_b = (Bp)[(k0) + (r32 | (hi << 5))]; \
                         S.st_k0 = load8<TIn>(ROW(Kp, k0, sr)); S.st_k1 = load8<TIn>(ROW(Kp, k0, 32 + sr)); } while (0)
#define SWRITE_HK(bf) do { *(bf16x8*)(K_lds + (bf) * SHM_K + kws) = S.st_k0; *(bf16x8*)(K_lds + (bf) * SHM_K + kws + 32 * 256) = S.st_k1; if (wid == 0) *(float*)(K_lds + 2 * SHM_K + NW * 64 * 4 + (bf) * 256 + (r32 | (hi << 5)) * 4) = S.st_b; } while (0)
#define SWRITE_HV(bf) do { *(bf16x8*)(V_lds + (bf) * SHM_V + vst0) = S.st_v0; *(bf16x8*)(V_lds + (bf) * SHM_V + vst1) = S.st_v1; } while (0)
#define SWRITE_H(bf) do { SWRITE_HV(bf); SWRITE_HK(bf); } while (0)
#define SLOAD_F(p, k0) do { S.sf0 = *(const f32x4*)ROW(p, k0, sr); S.sf1 = *(const f32x4*)(ROW(p, k0, sr) + 4);                \
                            S.sf2 = *(const f32x4*)ROW(p, k0, 32 + sr); S.sf3 = *(const f32x4*)(ROW(p, k0, 32 + sr) + 4); } while (0)
#define SWRITE_KF(bf) do { *(bf16x8*)(K_lds + (bf) * SHM_K + kws) = pack8(S.sf0, S.sf1); *(bf16x8*)(K_lds + (bf) * SHM_K + kws + 32 * 256) = pack8(S.sf2, S.sf3); } while (0)
#define SWRITE_VF(bf) do { *(bf16x8*)(V_lds + (bf) * SHM_V + vst0) = pack8(S.sf0, S.sf1); *(bf16x8*)(V_lds + (bf) * SHM_V + vst1) = pack8(S.sf2, S.sf3); } while (0)
template <class TIn, class TOut>
__device__ __forceinline__ void causal_swa_prime(const BlockRef<TIn, TOut>& cur, int W, char* lds, Seam<TIn>& S) {
    constexpr bool F32 = same_t<TIn, float>::v;
    const int tid = threadIdx.x, wid = __builtin_amdgcn_readfirstlane(tid >> 6), lane = tid & 63, r32 = lane & 31, hi = lane >> 5;
    const int sr = tid >> 4, sc = (tid & 15) * 8, kws = KSWZ(sr, sc * 2); char* K_lds = lds + 2 * SHM_V;
    const int kb0 = swa_jlo(cur.P0, W) * KVBLK;
    for (int d0 = 0; d0 < 8; ++d0) S.qr[d0] = load8<TIn>(cur.Q + (size_t)(wid * QBLK + r32) * D + d0 * 16 + hi * 8);
    if constexpr (F32) { SLOAD_F((const float*)cur.K, kb0); VMW(); SWRITE_KF(0); SBAR(); SLOAD_F((const float*)cur.V, kb0); }
    else { SLOAD_H(cur.K, cur.V, cur.KB, kb0); VMW(); SWRITE_HK(0); }
    __syncthreads();
}
template <class TIn, class TOut>
__device__ __forceinline__ void causal_swa_block(const BlockRef<TIn, TOut>& cur, const BlockRef<TIn, TOut>& nxt, int skv, int W, char* lds, Seam<TIn>& S) {
    constexpr bool F32 = same_t<TIn, float>::v;
    const int tid = threadIdx.x, wid = __builtin_amdgcn_readfirstlane(tid >> 6), lane = tid & 63, r32 = lane & 31, hi = lane >> 5;
    const int j_lo = swa_jlo(cur.P0, W);
    int j_hi = (cur.P0 + QB - 1) / KVBLK + 1; if (j_hi > skv / KVBLK) j_hi = skv / KVBLK;
    const int NT = j_hi - j_lo;
    const int kbn = swa_jlo(nxt.P0, W) * KVBLK;
    const int qlo = cur.P0 + wid * QBLK, qm = qlo + r32 - 4 * hi;
    char* V_lds = lds; char* K_lds = lds + 2 * SHM_V;
    float* ws = (float*)(lds + 2 * SHM_V + 2 * SHM_K) + wid * 64; float* li_l = ws, * al_l = ws + 32;
    float m_reg = -1e30f, l_reg = 0; f32x16 o[4] = {};
    const int sr = tid >> 4, sc = (tid & 15) * 8, vst0 = v_st(sr, sc), vst1 = v_st(32 + sr, sc), kws = KSWZ(sr, sc * 2);
    const int vb0 = (int)(uintptr_t)V_lds + v_rd_base(lane);
    const TIn* Kh = cur.K; const TIn* Vh = cur.V; const float* Bh = cur.KB;
#define RESC(a) do { if (__any((a) < 1.f)) { if (hi == 0) al_l[r32] = (a); asm volatile("s_waitcnt lgkmcnt(0)" ::: "memory");              \
                     for (int d_ = 0; d_ < 4; ++d_) for (int r = 0; r < 16; ++r) o[d_][r] *= al_l[crow(r, hi)]; } } while (0)
#define KBASE(t) ((j_lo + (t)) * KVBLK)
#define ACT(t) (KBASE(t) <= qlo + QBLK - 1 && KBASE(t) + KVBLK - 1 >= qlo - W + 1)
#define MASKT(P0_, P1_, t) do { const int kb_ = KBASE(t); if ((!SK || ACT(t)) && (kb_ + KVBLK - 1 > qlo || kb_ <= qlo + QBLK - 1 - W)) mask_tile(P0_, P1_, qm - kb_, (unsigned)W); } while (0)
    constexpr int NQL = F32 ? 16 : 8;
    constexpr bool SK = WSKIP && !F32;
#define SEAM_K0() do { VMWN(NQL); if constexpr (F32) { SWRITE_KF(0); SBAR(); SLOAD_F((const float*)nxt.V, kbn); } else { SWRITE_HK(0); } SBAR(); } while (0)
    f32x16 pA0, pA1, pB0, pB1; float mnA, mnB, alA, alB; bf16x8 pa0, pa1, pa2, pa3;
    if constexpr (F32) { VMW(); SWRITE_VF(0); SBAR(); } else { SWRITE_HV(0); SBAR(); }
    if (NT > 1) { if constexpr (F32) SLOAD_F((const float*)Kh, KBASE(1)); else SLOAD_H(Kh, Vh, Bh, KBASE(1)); }
    SBAR(); qkt<0, SK>(pA0, pA1, K_lds, r32, hi, S.qr, ACT(0));
    if constexpr (F32) { if (NT > 1) { VMW(); SWRITE_KF(1); SBAR(); SLOAD_F((const float*)Vh, KBASE(1)); } }
    MASKT(pA0, pA1, 0); partialSM(pA0, pA1, m_reg, mnA, alA);
    if (NT > 1) { VMW(); if constexpr (F32) { SWRITE_VF(1); SBAR(); if (NT > 2) SLOAD_F((const float*)Kh, KBASE(2)); } else SWRITE_H(1); }
    __syncthreads();
#define HALF_STEP(PX0, PX1, mnX, alX, PY0, PY1, alY, t, KB, VB, SB) do {                                                      \
        SBAR(); qkt<KB, SK>(PX0, PX1, K_lds, r32, hi, S.qr, ACT(t));                                             \
        finishSM(PY0, PY1, alY, l_reg, pa0, pa1, pa2, pa3); SBAR();                                                           \
        if ((t) + 1 < NT) { if constexpr (F32) { VMW(); SWRITE_KF(SB); SBAR(); SLOAD_F((const float*)Vh, KBASE((t) + 1)); }  \
                            else { SLOAD_H(Kh, Vh, Bh, KBASE((t) + 1)); } SBAR(); }                                               \
        pv_tile<VB, SK>(o, vb0, pa0, pa1, pa2, pa3, ACT((t) - 1)); MASKT(PX0, PX1, (t)); partialSM(PX0, PX1, m_reg, mnX, alX);                                        \
        __syncthreads();                                                                                                      \
        if ((t) + 1 < NT) { VMW(); if constexpr (F32) { SWRITE_VF(SB); SBAR(); if ((t) + 2 < NT) SLOAD_F((const float*)Kh, KBASE((t) + 2)); } \
                            else { SWRITE_H(SB); } }                                                                          \
        RESC(alX); __syncthreads(); } while (0)
    for (int t = 1; t + 1 < NT; t += 2) {
        HALF_STEP(pB0, pB1, mnB, alB, pA0, pA1, alA, t, 1, 0, 0);
        HALF_STEP(pA0, pA1, mnA, alA, pB0, pB1, alB, t + 1, 0, 1, 1);
    }
    const bool even = (NT & 1) == 0;
    if (even) { SBAR(); qkt<1, SK>(pB0, pB1, K_lds, r32, hi, S.qr, ACT(NT - 1)); SBAR(); }
#define QROW(e) (nxt.Q + (size_t)(wid * QBLK + r32) * D + ((e) >> 1) * 16 + hi * 8 + ((e) & 1) * 4)
    if constexpr (F32) { SLOAD_F((const float*)nxt.K, kbn); SBAR();
#pragma unroll
        for (int e = 0; e < 8; ++e) S.tq[e] = *(const f32x4*)QROW(e); }
    else { SLOAD_H(nxt.K, nxt.V, nxt.KB, kbn); SBAR();
#pragma unroll
        for (int d0 = 0; d0 < 8; ++d0) S.qr[d0] = load8<TIn>(nxt.Q + (size_t)(wid * QBLK + r32) * D + d0 * 16 + hi * 8); }
    SBAR();
    finishSM(pA0, pA1, alA, l_reg, pa0, pa1, pa2, pa3); SBAR();
    if constexpr (F32) {
#pragma unroll
        for (int e = 8; e < 16; ++e) S.tq[e] = *(const f32x4*)QROW(e); SBAR(); }
#undef QROW
    pv_tile<0, SK>(o, vb0, pa0, pa1, pa2, pa3, ACT(even ? NT - 2 : NT - 1));
    if (even) { MASKT(pB0, pB1, NT - 1); partialSM(pB0, pB1, m_reg, mnB, alB); __syncthreads(); RESC(alB);
        finishSM(pB0, pB1, alB, l_reg, pa0, pa1, pa2, pa3); SBAR(); pv_tile<1, SK>(o, vb0, pa0, pa1, pa2, pa3, ACT(NT - 1)); }
    SBAR(); SEAM_K0();
    if (hi == 0) li_l[r32] = l_reg; asm volatile("s_waitcnt lgkmcnt(0)" ::: "memory");
    float rli[16];
#pragma unroll
    for (int r = 0; r < 16; ++r) rli[r] = __builtin_amdgcn_rcpf(li_l[crow(r, hi)]);
    TOut* Ow = cur.O + (size_t)((wid * QBLK + 4 * hi) * OSTR + r32); const unsigned short* Zw = cur.Z + (size_t)((wid * QBLK + 4 * hi) * ZSTR + r32);
#pragma unroll
    for (int r = 0; r < 16; ++r) { const int orow = (r & 3) + 8 * (r >> 2);
#pragma unroll
        for (int d0 = 0; d0 < 4; ++d0) { const float zg = __uint_as_float((unsigned)Zw[orow * ZSTR + d0 * 32] << 16);
            const float v = o[d0][r] * rli[r] * zg * __builtin_amdgcn_rcpf(1.f + __builtin_amdgcn_exp2f(-1.4426950408889634f * zg));
            if constexpr (same_t<TOut, float>::v) { Ow[orow * OSTR + d0 * 32] = v; }
            else { const float vn = __shfl_xor(v, 1);
                   if ((r32 & 1) == 0) *(unsigned*)(Ow + orow * OSTR + d0 * 32) = cvtpk(v, vn); } }
        if (r & 1) asm volatile("" ::: "memory"); }
    if constexpr (F32) {
#pragma unroll
        for (int d0 = 0; d0 < 8; ++d0) S.qr[d0] = pack8(S.tq[2 * d0], S.tq[2 * d0 + 1]); }
    __syncthreads();
#undef RESC
#undef KBASE
#undef ACT
#undef MASKT
#undef SEAM_K0
#undef HALF_STEP
}
#undef ROW
#undef VMW
#undef VMWN
#undef SLOAD_H
#undef SWRITE_HK
#undef SWRITE_HV
#undef SWRITE_H
#undef SLOAD_F
#undef SWRITE_KF
#undef SWRITE_VF

}
constexpr int LDS_TOTAL = 159744;
constexpr int GEMM_X_OFF = 131072;

__device__ __forceinline__ int phys2log(int n) {
    if (n < 1536) return n;
    if (n < 2048) return n + 8;
    if (n < 3584) return n + 8;
    if (n < 4096) return n + 12;
    return n + 12;
}

__device__ void phase_prologue(const Params& p, unsigned char* lds) {
    const int tid = threadIdx.x, lane = tid & 63, w = tid >> 6;
    float* L = (float*)lds;
    if (blockIdx.x == 0 && tid < 16) { ((unsigned*)(p.ws + WS_CTRL))[tid] = 0u; }
    if (blockIdx.x < 48) {
        const int j = blockIdx.x * 64 + lane;
        float acc[8] = {0.f, 0.f, 0.f, 0.f, 0.f, 0.f, 0.f, 0.f};
        for (int k = w * 128; k < w * 128 + 128; ++k) { const float wv = p.w_ada[(size_t)k * 3072 + j];
#pragma unroll
            for (int b = 0; b < 8; ++b) acc[b] += p.c[b * 1024 + k] * wv; }
#pragma unroll
        for (int b = 0; b < 8; ++b) L[(w * 8 + b) * 64 + lane] = acc[b];
        __syncthreads();
        { const int b = w; float s = p.b_ada[j];
#pragma unroll
          for (int ww = 0; ww < 8; ++ww) s += L[(ww * 8 + b) * 64 + lane];
          ((float*)(p.ws + WS_MOD))[b * 3072 + j] = s; }
        __syncthreads();
    }
    { const int gt = blockIdx.x * 512 + tid;
      if (gt < 12288) { const int j = gt >> 10, k = gt & 1023; const int col = j < 8 ? 1536 + j : 3592 + (j - 8);
          ((float*)(p.ws + WS_WSMALL))[gt] = p.w_in[(size_t)k * DIN + col]; } }
    unsigned short* WIN_T = (unsigned short*)(p.ws + WS_WIN_T); unsigned short* WO2_T = (unsigned short*)(p.ws + WS_WO2_T); unsigned short* WOUT2_T = (unsigned short*)(p.ws + WS_WOUT2_T);
    for (int tile = blockIdx.x; tile < 2048; tile += gridDim.x) {
        const float* src; int sld; unsigned short* dst; int dld; unsigned short* dst2 = nullptr;
        if (tile < 1536) { const int kt = tile / 96, nt = tile % 96; src = p.w_in + (size_t)(kt * 64) * DIN + phys2log(nt * 64); sld = DIN; dst = WIN_T + (size_t)(nt * 64) * 1024 + kt * 64; dld = 1024; }
        else if (tile < 1792) { const int idx = tile - 1536, nt = idx & 31, kt = idx >> 5; src = (nt < 16 ? p.w_o_gdn : p.w_o_fox) + (size_t)(kt * 64) * 1024 + (nt & 15) * 64; sld = 1024; dst = WO2_T + (size_t)((nt & 15) * 64) * 1024 + (nt < 16 ? 0 : 512) + kt * 64; dld = 1024; }
        else { const int idx = tile - 1792, nt = idx & 15, kt = idx >> 4; src = p.w_out + (size_t)(kt * 64) * 1024 + nt * 64; sld = 1024; dst = WOUT2_T + (size_t)(nt * 64) * 2048 + kt * 64; dld = 2048; dst2 = dst + 1024; }
        { const int i = tid >> 3, js = (tid & 7) * 8;
          const float4 a = *(const float4*)(src + (size_t)i * sld + js), b = *(const float4*)(src + (size_t)i * sld + js + 4);
          float* r = L + i * 65 + js; r[0] = a.x; r[1] = a.y; r[2] = a.z; r[3] = a.w; r[4] = b.x; r[5] = b.y; r[6] = b.z; r[7] = b.w; }
        __syncthreads();
        { const int n = tid >> 3, ks = (tid & 7) * 8; float v[8];
#pragma unroll
          for (int q = 0; q < 8; ++q) v[q] = L[(ks + q) * 65 + n];
          uint4 o; o.x = pk_bf16(v[0], v[1]); o.y = pk_bf16(v[2], v[3]); o.z = pk_bf16(v[4], v[5]); o.w = pk_bf16(v[6], v[7]);
          *(uint4*)(dst + (size_t)n * dld + ks) = o; if (dst2) *(uint4*)(dst2 + (size_t)n * dld + ks) = o; }
        __syncthreads();
    }
}

__device__ void phase_prepass(const Params& p, unsigned char* lds) {
    const int tid = threadIdx.x, lane = tid & 63, w = tid >> 6, l5 = lane & 31, up = lane >> 5;
    float* Wsm = (float*)lds;
    { const float* src = (const float*)(p.ws + WS_WSMALL); for (int i = tid; i < 12288; i += 512) Wsm[i] = src[i]; }
    __syncthreads();
    const float* mod = (const float*)(p.ws + WS_MOD);
    unsigned short* HB = (unsigned short*)(p.ws + WS_HB);
    float* GDEC = (float*)(p.ws + WS_GDEC); float* BETA = (float*)(p.ws + WS_BETA); float* LOGF = (float*)(p.ws + WS_LOGF);
    const int nwave = gridDim.x * 8, rows_per = MTOK / nwave;
    const int gw = blockIdx.x * 8 + w;
    const float gA = l5 < 4 ? -__expf(p.A_log[l5 & 3]) : 0.f;
    const float gbias = l5 < 4 ? p.dt_bias[l5 & 3] : (l5 >= 8 && l5 < 12 ? p.b_f[l5 & 3] : 0.f);
    float* gdst = (l5 < 4 ? GDEC : (l5 < 8 ? BETA : LOGF)) + (l5 & 3);
    for (int r0 = gw * rows_per; r0 < (gw + 1) * rows_per; r0 += 32) {
        const int b = r0 >> 13;
        float4 gs[4], sh[4];
#pragma unroll
        for (int i = 0; i < 4; ++i) { const int e = i * 256 + lane * 4; const float4 g = *(const float4*)(p.g_norm + e), sc = *(const float4*)(mod + b * 3072 + 1024 + e); sh[i] = *(const float4*)(mod + b * 3072 + e);
            gs[i].x = g.x * (1.f + sc.x); gs[i].y = g.y * (1.f + sc.y); gs[i].z = g.z * (1.f + sc.z); gs[i].w = g.w * (1.f + sc.w); }
        const int rend = (r0 + 32 < (gw + 1) * rows_per) ? r0 + 32 : (gw + 1) * rows_per;
        float4 xn0[4], xn1[4];
        { const int rb = (r0 + 1 < rend) ? r0 + 1 : r0;
#pragma unroll
          for (int i = 0; i < 4; ++i) { xn0[i] = *(const float4*)(p.x + (size_t)r0 * DM + i * 256 + lane * 4); xn1[i] = *(const float4*)(p.x + (size_t)rb * DM + i * 256 + lane * 4); } }
#pragma unroll 1
        for (int r = r0; r < rend; r += 2) {
            const bool hasb = r + 1 < rend;
            float4 xa[4], xb[4]; float ssa = 0.f, ssb = 0.f;
#pragma unroll
            for (int i = 0; i < 4; ++i) { xa[i] = xn0[i]; xb[i] = xn1[i];
                ssa += xa[i].x * xa[i].x + xa[i].y * xa[i].y + xa[i].z * xa[i].z + xa[i].w * xa[i].w; ssb += xb[i].x * xb[i].x + xb[i].y * xb[i].y + xb[i].z * xb[i].z + xb[i].w * xb[i].w; }
            { const int ra = (r + 2 < rend) ? r + 2 : r, rb = (r + 3 < rend) ? r + 3 : ra;
#pragma unroll
              for (int i = 0; i < 4; ++i) { xn0[i] = *(const float4*)(p.x + (size_t)ra * DM + i * 256 + lane * 4); xn1[i] = *(const float4*)(p.x + (size_t)rb * DM + i * 256 + lane * 4); } }
            float rstd_a, rstd_b;
            { float v = up ? ssb : ssa; const float snd = up ? ssa : ssb; v += __shfl_xor(snd, 32);
#pragma unroll
              for (int o = 16; o >= 1; o >>= 1) v += __shfl_xor(v, o);
              const float ta = __shfl(v, 0), tb = __shfl(v, 32);
              rstd_a = __builtin_amdgcn_rsqf(ta * (1.0f / 1024.0f) + 1e-6f); rstd_b = __builtin_amdgcn_rsqf(tb * (1.0f / 1024.0f) + 1e-6f); }
#pragma unroll
            for (int i = 0; i < 4; ++i) {
                xa[i].x = xa[i].x * rstd_a * gs[i].x + sh[i].x; xa[i].y = xa[i].y * rstd_a * gs[i].y + sh[i].y; xa[i].z = xa[i].z * rstd_a * gs[i].z + sh[i].z; xa[i].w = xa[i].w * rstd_a * gs[i].w + sh[i].w;
                xb[i].x = xb[i].x * rstd_b * gs[i].x + sh[i].x; xb[i].y = xb[i].y * rstd_b * gs[i].y + sh[i].y; xb[i].z = xb[i].z * rstd_b * gs[i].z + sh[i].z; xb[i].w = xb[i].w * rstd_b * gs[i].w + sh[i].w;
                uint2 o; o.x = pk_bf16(xa[i].x, xa[i].y); o.y = pk_bf16(xa[i].z, xa[i].w); *(uint2*)(HB + (size_t)r * DM + i * 256 + lane * 4) = o;
                if (hasb) { uint2 o2; o2.x = pk_bf16(xb[i].x, xb[i].y); o2.y = pk_bf16(xb[i].z, xb[i].w); *(uint2*)(HB + (size_t)(r + 1) * DM + i * 256 + lane * 4) = o2; } }
            float mine = 0.f;
#pragma unroll
            for (int j = 0; j < 12; ++j) { float da = 0.f, db = 0.f;
#pragma unroll
                for (int i = 0; i < 4; ++i) { const float4 wv = *(const float4*)(Wsm + j * 1024 + i * 256 + lane * 4);
                    da += xa[i].x * wv.x + xa[i].y * wv.y + xa[i].z * wv.z + xa[i].w * wv.w; db += xb[i].x * wv.x + xb[i].y * wv.y + xb[i].z * wv.z + xb[i].w * wv.w; }
                float v = up ? db : da; const float snd = up ? da : db; v += __shfl_xor(snd, 32);
#pragma unroll
                for (int o = 16; o >= 1; o >>= 1) v += __shfl_xor(v, o);
                if (l5 == j) mine = v; }
            if (l5 < 12 && (up == 0 || hasb)) {
                const float t = mine + gbias, u = l5 < 4 ? t : -t;
                const float sp = fmaxf(u, 0.f) + __logf(1.f + __expf(-fabsf(u)));
                gdst[(size_t)(r + up) * 4] = l5 < 4 ? gA * sp : (l5 < 8 ? __expf(-sp) : -sp); }
        }
    }
    __syncthreads();
}

__device__ void phase_cumsum(const Params& p, unsigned char* lds) {
    if (blockIdx.x >= 32) return;
    const int tid = threadIdx.x, lane = tid & 63, w = tid >> 6, bh = blockIdx.x, b = bh >> 2, h = bh & 3;
    float* L = (float*)lds;
    const float* LOGF = (const float*)(p.ws + WS_LOGF); float* KB = (float*)(p.ws + WS_KBIAS) + (size_t)bh * SEQ;
    float v[16]; float s = 0.f;
#pragma unroll
    for (int i = 0; i < 16; ++i) { s += LOGF[((size_t)b * SEQ + tid * 16 + i) * 4 + h]; v[i] = s; }
    float incl = s;
#pragma unroll
    for (int o = 1; o < 64; o <<= 1) { const float t = __shfl_up(incl, o); if (lane >= o) incl += t; }
    if (lane == 63) L[w] = incl;
    __syncthreads();
    float pre = incl - s;
    for (int ww = 0; ww < w; ++ww) pre += L[ww];
#pragma unroll
    for (int i = 0; i < 16; ++i) KB[tid * 16 + i] = -(pre + v[i]) * 11.313708498984761f;
    __syncthreads();
}

typedef float f32x2 __attribute__((ext_vector_type(2)));
__device__ void gdn_stage_chunk(const Params& p, float* Q, float* K, float* V, float* GA, float* GB, int b, int h, int t0) {
    const int tid = threadIdx.x; const int s = tid >> 3, dg = tid & 7;
    const unsigned short* GQKV = (const unsigned short*)(p.ws + WS_GQKV);
#pragma unroll 1
    for (int part = 0; part < 3; ++part) {
        const int ch0 = part * 512 + h * 128 + dg * 16;
        float a[16];
#pragma unroll
        for (int c = 0; c < 16; ++c) a[c] = 0.f;
#pragma unroll
        for (int i = 0; i < 4; ++i) { const int tt = t0 + s - 3 + i;
            if (tt >= 0) { const uint4 u0 = *(const uint4*)(GQKV + ((size_t)b * SEQ + tt) * 1536 + ch0), u1 = *(const uint4*)(GQKV + ((size_t)b * SEQ + tt) * 1536 + ch0 + 8);
                const unsigned uu[8] = {u0.x, u0.y, u0.z, u0.w, u1.x, u1.y, u1.z, u1.w};
                const float* wp = p.conv_w + i * 1536 + ch0;
#pragma unroll
                for (int q = 0; q < 8; ++q) { a[2 * q] += wp[2 * q] * __uint_as_float(uu[q] << 16); a[2 * q + 1] += wp[2 * q + 1] * __uint_as_float(uu[q] & 0xffff0000u); } } }
        float ss = 0.f;
#pragma unroll
        for (int c = 0; c < 16; ++c) { a[c] = siluf_(a[c]); ss += a[c] * a[c]; }
        float* dst = V;
        if (part < 2) { ss += __shfl_xor(ss, 1); ss += __shfl_xor(ss, 2); ss += __shfl_xor(ss, 4);
            float r = 1.0f / sqrtf(ss + 1e-6f); if (part == 0) r *= 0.08838834764831845f;
#pragma unroll
            for (int c = 0; c < 16; ++c) a[c] *= r;
            dst = part == 0 ? Q : K; }
#pragma unroll
        for (int c = 0; c < 16; c += 4) *(float4*)(dst + s * 128 + dg * 16 + c) = make_float4(a[c], a[c + 1], a[c + 2], a[c + 3]);
    }
    if (tid < 64) { GA[tid] = __expf(((const float*)(p.ws + WS_GDEC))[((size_t)b * SEQ + t0 + tid) * 4 + h]); GB[tid] = ((const float*)(p.ws + WS_BETA))[((size_t)b * SEQ + t0 + tid) * 4 + h]; }
}
__device__ void gdn_epilogue_chunk(const Params& p, const float* O, int b, int h, int t0) {
    const int tid = threadIdx.x; const int s = tid >> 3, dg = tid & 7;
    float o[16]; float ss = 0.f;
#pragma unroll
    for (int c = 0; c < 16; c += 4) { const float4 v = *(const float4*)(O + s * 128 + dg * 16 + c); o[c] = v.x; o[c + 1] = v.y; o[c + 2] = v.z; o[c + 3] = v.w; }
#pragma unroll
    for (int c = 0; c < 16; ++c) ss += o[c] * o[c];
    ss += __shfl_xor(ss, 1); ss += __shfl_xor(ss, 2); ss += __shfl_xor(ss, 4);
    const float rstd = 1.0f / sqrtf(ss * (1.0f / 128.0f) + 1e-6f);
    const size_t tok = (size_t)b * SEQ + t0 + s;
    const unsigned short* zp = (const unsigned short*)(p.ws + WS_ZG) + tok * 3072 + h * 128 + dg * 16;
    const uint4 z0 = *(const uint4*)zp, z1 = *(const uint4*)(zp + 8);
    const unsigned zz[8] = {z0.x, z0.y, z0.z, z0.w, z1.x, z1.y, z1.z, z1.w};
    unsigned ow[8];
#pragma unroll
    for (int q = 0; q < 8; ++q) { const float za = __uint_as_float(zz[q] << 16), zb = __uint_as_float(zz[q] & 0xffff0000u);
        const float va = o[2 * q] * rstd * p.g_gdn_out[dg * 16 + 2 * q] * siluf_(za), vb = o[2 * q + 1] * rstd * p.g_gdn_out[dg * 16 + 2 * q + 1] * siluf_(zb);
        ow[q] = pk_bf16(va, vb); }
    unsigned short* dst = (unsigned short*)(p.ws + WS_HB) + tok * 1024 + h * 128 + dg * 16;
    *(uint4*)dst = make_uint4(ow[0], ow[1], ow[2], ow[3]); *(uint4*)(dst + 8) = make_uint4(ow[4], ow[5], ow[6], ow[7]);
}
__device__ __forceinline__ void gdn_epilogue_chunk_z(const Params& p, const float* O, int b, int h, int t0, uint4 z0, uint4 z1) {
    const int tid = threadIdx.x; const int s = tid >> 3, dg = tid & 7;
    float o[16]; float ss = 0.f;
#pragma unroll
    for (int c = 0; c < 16; c += 4) { const float4 v = *(const float4*)(O + s * 128 + dg * 16 + c); o[c] = v.x; o[c + 1] = v.y; o[c + 2] = v.z; o[c + 3] = v.w; }
#pragma unroll
    for (int c = 0; c < 16; ++c) ss += o[c] * o[c];
    ss += __shfl_xor(ss, 1); ss += __shfl_xor(ss, 2); ss += __shfl_xor(ss, 4);
    const float rstd = 1.0f / sqrtf(ss * (1.0f / 128.0f) + 1e-6f);
    const size_t tok = (size_t)b * SEQ + t0 + s;
    const unsigned zz[8] = {z0.x, z0.y, z0.z, z0.w, z1.x, z1.y, z1.z, z1.w};
    unsigned ow[8];
#pragma unroll
    for (int q = 0; q < 8; ++q) { const float za = __uint_as_float(zz[q] << 16), zb = __uint_as_float(zz[q] & 0xffff0000u);
        const float va = o[2 * q] * rstd * p.g_gdn_out[dg * 16 + 2 * q] * siluf_(za), vb = o[2 * q + 1] * rstd * p.g_gdn_out[dg * 16 + 2 * q + 1] * siluf_(zb);
        ow[q] = pk_bf16(va, vb); }
    unsigned short* dst = (unsigned short*)(p.ws + WS_HB) + tok * 1024 + h * 128 + dg * 16;
    *(uint4*)dst = make_uint4(ow[0], ow[1], ow[2], ow[3]); *(uint4*)(dst + 8) = make_uint4(ow[4], ow[5], ow[6], ow[7]);
}
__device__ void gdn_seq_unit(const Params& p, unsigned char* lds, int bh) {
    float* Q = (float*)lds; float* K = Q + 8192; float* V = K + 8192; float* O = V + 8192; float* GA = O + 8192; float* GB = GA + 64;
    const int tid = threadIdx.x, b = bh >> 2, h = bh & 3;
    f32x2 st[64];
#pragma unroll
    for (int i = 0; i < 64; ++i) st[i] = (f32x2){0.f, 0.f};
    for (int ch = 0; ch < SEQ / 64; ++ch) {
        const int t0 = ch * 64;
        __syncthreads();
        gdn_stage_chunk(p, Q, K, V, GA, GB, b, h, t0);
        __syncthreads();
        if (tid < 128) {
#pragma unroll 1
            for (int s = 0; s < 64; ++s) {
                const float a = GA[s], be = GB[s], v = V[s * 128 + tid];
                f32x2 ks0 = {0.f, 0.f}, ks1 = {0.f, 0.f};
#pragma unroll
                for (int i = 0; i < 64; i += 2) { const float4 kv = *(const float4*)(K + s * 128 + 2 * i); ks0 += (f32x2){kv.x, kv.y} * st[i]; ks1 += (f32x2){kv.z, kv.w} * st[i + 1]; if ((i & 14) == 14) asm volatile("" ::: "memory"); }
                const float kS = a * ((ks0.x + ks0.y) + (ks1.x + ks1.y));
                const float dl = be * (v - kS);
                f32x2 os0 = {0.f, 0.f}, os1 = {0.f, 0.f};
#pragma unroll
                for (int i = 0; i < 64; i += 2) { const float4 kv = *(const float4*)(K + s * 128 + 2 * i); const float4 qv = *(const float4*)(Q + s * 128 + 2 * i);
                    st[i] = st[i] * a + (f32x2){kv.x, kv.y} * dl; st[i + 1] = st[i + 1] * a + (f32x2){kv.z, kv.w} * dl;
                    os0 += (f32x2){qv.x, qv.y} * st[i]; os1 += (f32x2){qv.z, qv.w} * st[i + 1]; if ((i & 6) == 6) asm volatile("" ::: "memory"); }
                O[s * 128 + tid] = (os0.x + os0.y) + (os1.x + os1.y);
            }
        }
        __syncthreads();
        gdn_epilogue_chunk(p, O, b, h, t0);
    }
    __syncthreads();
}

#ifndef PREP_REP
#define PREP_REP 0
#endif
namespace gdn2 {
typedef short bf16x8 __attribute__((ext_vector_type(8)));
typedef float f32x16 __attribute__((ext_vector_type(16)));
constexpr int RK = 272, RT_ = 144;
constexpr int O_QN = 0, O_KN = 17408, O_KT = 34816, O_VT = 53248, O_L = 71680, O_RT = 88064, O_TMU = 92160, O_TMW = 101376, O_QKM = 110592, O_ST = 119808, O_G = 154624, O_END = 155648;
constexpr int O_W = O_KN, O_VNT = O_VT, O_VNTD = O_L, O_OBUF = 0;
__device__ __forceinline__ int crow(int r, int hi) { return (r & 3) + 8 * (r >> 2) + 4 * hi; }
#define CRC(i) (((i) & 3) + 8 * ((i) >> 2))
__device__ __forceinline__ unsigned short f2bf(float v) { return (unsigned short)(pk_bf16c(v, 0.f) & 0xffffu); }
template <int KS> __device__ __forceinline__ f32x16 mm32(f32x16 acc, const unsigned char* A, int lda, const unsigned char* B, int ldb, int lane) {
    const int r = lane & 31, hi = lane >> 5;
    const unsigned char* ap = A + r * lda + hi * 16; const unsigned char* bp = B + r * ldb + hi * 16;
#pragma unroll
    for (int ks = 0; ks < KS; ++ks) { const bf16x8 a = *(const bf16x8*)(ap + ks * 32); const bf16x8 b = *(const bf16x8*)(bp + ks * 32); acc = __builtin_amdgcn_mfma_f32_32x32x16_bf16(a, b, acc, 0, 0, 0); }
    return acc;
}
struct RawRegs { uint4 r[8]; };
constexpr int O_RAW = 92160, RAWROW = 784, O_CW = 144896;
__device__ __forceinline__ void stage_load(const Params& p, RawRegs& R, int b, int h, int t0) {
    const int tid = threadIdx.x; const unsigned short* GQKV = (const unsigned short*)(p.ws + WS_GQKV);
#pragma unroll
    for (int j = 0; j < 4; ++j) { const int id = tid + 512 * j; const int r = id / 24, rem = id - r * 24, part = rem >> 3, dg = rem & 7; const int tt = t0 - 3 + r;
        if (id < 1608 && tt >= 0) { const unsigned short* src = GQKV + ((size_t)b * SEQ + tt) * 1536 + part * 512 + h * 128 + dg * 16; R.r[2 * j] = *(const uint4*)src; R.r[2 * j + 1] = *(const uint4*)(src + 8); }
        else { R.r[2 * j] = make_uint4(0u, 0u, 0u, 0u); R.r[2 * j + 1] = make_uint4(0u, 0u, 0u, 0u); } }
}
__device__ __forceinline__ void stage_store_raw(unsigned char* lds, const RawRegs& R) {
    const int tid = threadIdx.x;
#pragma unroll
    for (int j = 0; j < 4; ++j) { const int id = tid + 512 * j; if (id < 1608) { const int r_ = id / 24, rem_ = id - r_ * 24; unsigned char* d_ = lds + O_RAW + r_ * RAWROW + rem_ * 32; *(uint4*)d_ = R.r[2 * j]; *(uint4*)(d_ + 16) = R.r[2 * j + 1]; } }
}
__device__ void stage_compute(const Params& p, unsigned char* lds, int b, int h, int t0) {
    const int tid = threadIdx.x; const int s = tid & 63, dg = __builtin_amdgcn_readfirstlane(tid >> 6);
    float* red = (float*)(lds + O_RT);
    float aq[16], ak[16];
#pragma unroll
    for (int part = 2; part >= 0; --part) {
        float a[16];
#pragma unroll
        for (int c = 0; c < 16; ++c) a[c] = 0.f;
#pragma unroll
        for (int i = 0; i < 4; ++i) { const unsigned char* rp = lds + O_RAW + (s + i) * RAWROW + (part * 8 + dg) * 32;
            const uint4 u0 = *(const uint4*)rp, u1 = *(const uint4*)(rp + 16);
            const unsigned uu[8] = {u0.x, u0.y, u0.z, u0.w, u1.x, u1.y, u1.z, u1.w};
            const float* wp = (const float*)(lds + O_CW) + (part * 4 + i) * 128 + dg * 16;
            float wv[16];
#pragma unroll
            for (int q = 0; q < 4; ++q) { const float4 t4 = *(const float4*)(wp + 4 * q); wv[4 * q] = t4.x; wv[4 * q + 1] = t4.y; wv[4 * q + 2] = t4.z; wv[4 * q + 3] = t4.w; }
#pragma unroll
            for (int q = 0; q < 8; ++q) { a[2 * q] += wv[2 * q] * __uint_as_float(uu[q] << 16); a[2 * q + 1] += wv[2 * q + 1] * __uint_as_float(uu[q] & 0xffff0000u); } }
        float ss = 0.f;
#pragma unroll
        for (int c = 0; c < 16; ++c) { a[c] = a[c] * __builtin_amdgcn_rcpf(1.f + __builtin_amdgcn_exp2f(-1.4426950408889634f * a[c])); ss += a[c] * a[c]; }
        if (part == 2) { unsigned char* dt = lds + O_VT + (dg * 16) * RT_ + s * 2;
#pragma unroll
            for (int c = 0; c < 16; ++c) *(unsigned short*)(dt + c * RT_) = f2bf(a[c]); }
        else { red[(part * 8 + dg) * 64 + s] = ss;
#pragma unroll
            for (int c = 0; c < 16; ++c) { if (part == 1) ak[c] = a[c]; else aq[c] = a[c]; } }
    }
    __syncthreads();
    { float sq = 0.f, sk = 0.f;
#pragma unroll
      for (int d = 0; d < 8; ++d) { sq += red[d * 64 + s]; sk += red[(8 + d) * 64 + s]; }
      const float rq = __builtin_amdgcn_rsqf(sq + 1e-6f) * 0.08838834764831845f, rk = __builtin_amdgcn_rsqf(sk + 1e-6f);
#pragma unroll
      for (int c = 0; c < 16; ++c) { aq[c] *= rq; ak[c] *= rk; }
      unsigned char* dq = lds + O_QN + s * RK + dg * 32; unsigned char* dk = lds + O_KN + s * RK + dg * 32;
      *(uint4*)dq = make_uint4(pk_bf16c(aq[0], aq[1]), pk_bf16c(aq[2], aq[3]), pk_bf16c(aq[4], aq[5]), pk_bf16c(aq[6], aq[7]));
      *(uint4*)(dq + 16) = make_uint4(pk_bf16c(aq[8], aq[9]), pk_bf16c(aq[10], aq[11]), pk_bf16c(aq[12], aq[13]), pk_bf16c(aq[14], aq[15]));
      *(uint4*)dk = make_uint4(pk_bf16c(ak[0], ak[1]), pk_bf16c(ak[2], ak[3]), pk_bf16c(ak[4], ak[5]), pk_bf16c(ak[6], ak[7]));
      *(uint4*)(dk + 16) = make_uint4(pk_bf16c(ak[8], ak[9]), pk_bf16c(ak[10], ak[11]), pk_bf16c(ak[12], ak[13]), pk_bf16c(ak[14], ak[15]));
      unsigned char* dt = lds + O_KT + (dg * 16) * RT_ + s * 2;
#pragma unroll
      for (int c = 0; c < 16; ++c) *(unsigned short*)(dt + c * RT_) = f2bf(ak[c]); }
    if (tid < 64) { float* G = (float*)(lds + O_G);
        float g = ((const float*)(p.ws + WS_GDEC))[((size_t)b * SEQ + t0 + tid) * 4 + h];
#pragma unroll
        for (int o = 1; o < 64; o <<= 1) { const float t = __shfl_up(g, o); if (tid >= o) g += t; }
        const float gl = __shfl(g, 63);
        G[tid] = g; G[64 + tid] = ((const float*)(p.ws + WS_BETA))[((size_t)b * SEQ + t0 + tid) * 4 + h]; G[128 + tid] = __expf(g); G[192 + tid] = __expf(gl - g); }
}
__device__ __forceinline__ unsigned char* prepA(const Params& p, int bh, int ch) { return (unsigned char*)p.out + (size_t)(bh * 128 + ch) * 65536; }
__device__ __forceinline__ unsigned char* prepB(const Params& p, int bh, int ch) { return p.ws + WS_PREPB + (size_t)(bh * 128 + ch) * 8704; }
__device__ void prep_unit(const Params& p, unsigned char* lds, int bh, int ch, RawRegs& R, bool has_next, int bh_n, int ch_n) {
    const int tid = threadIdx.x, lane = tid & 63, w = tid >> 6, hi = lane >> 5, l31 = lane & 31, b = bh >> 2, h = bh & 3;
    float* Lf = (float*)(lds + O_L); float* RTm = (float*)(lds + O_RT); const float* GC = (const float*)(lds + O_G); const float* BE = GC + 64; const float* EG = GC + 128;
    const int t0 = ch * 64;
    unsigned char* ga = prepA(p, bh, ch); unsigned char* gb = prepB(p, bh, ch);
    __syncthreads();
    stage_store_raw(lds, R);
    if (has_next) stage_load(p, R, bh_n >> 2, bh_n & 3, ch_n * 64);
    __syncthreads();
    stage_compute(p, lds, b, h, t0);
    __syncthreads();
    if (PREP_REP & 1) { stage_compute(p, lds, b, h, t0); __syncthreads(); }
#pragma unroll
    for (int i = 0; i < 2; ++i) { const int pc = tid + i * 512;
        *(uint4*)(ga + 32768 + pc * 16) = *(const uint4*)(lds + O_QN + (pc >> 4) * RK + (pc & 15) * 16);
        *(uint4*)(ga + 49152 + pc * 16) = *(const uint4*)(lds + O_KT + (pc >> 3) * RT_ + (pc & 7) * 16); }
    if (tid < 32) *(uint4*)(gb + 8192 + tid * 16) = *(const uint4*)(lds + O_G + 512 + tid * 16);
#pragma unroll 1
    for (int rep2 = 0; rep2 < ((PREP_REP & 16) ? 2 : 1); ++rep2) {
#pragma unroll 1
    for (int rep = 0; rep < ((PREP_REP & 2) ? 2 : 1); ++rep) {
    { const int tr = (w >> 1) & 1, tc = w & 1; const bool isQ = w >= 4;
      f32x16 acc;
#pragma unroll
      for (int i = 0; i < 16; ++i) acc[i] = 0.f;
      acc = mm32<8>(acc, lds + (isQ ? O_QN : O_KN) + tr * 32 * RK, RK, lds + O_KN + tc * 32 * RK, RK, lane);
      const int s = tc * 32 + l31; const float gs = GC[s]; const int cb = tr * 32 + 4 * hi;
      const float* gcb = GC + cb; const float* beb = BE + cb; float* lfb = Lf + cb * 64 + s; unsigned char* qkb = lds + O_QKM + cb * RT_ + s * 2;
#pragma unroll
      for (int i = 0; i < 16; ++i) { const int c = cb + CRC(i); const float dec = __expf(fminf(gcb[CRC(i)] - gs, 0.f));
          if (!isQ) lfb[CRC(i) * 64] = (c > s) ? beb[CRC(i)] * acc[i] * dec : 0.f;
          else *(unsigned short*)(qkb + CRC(i) * RT_) = f2bf((c >= s) ? acc[i] * dec : 0.f); } }
    __syncthreads();
    }
    *(uint4*)(gb + tid * 16) = *(const uint4*)(lds + O_QKM + (tid >> 3) * RT_ + (tid & 7) * 16);
    if (w == 0) { const int g4 = lane >> 4, j = lane & 15; float t[16];
        const float* Lb = Lf + (16 * g4) * 64 + 16 * g4;
#pragma unroll
        for (int i = 0; i < 16; ++i) { float a = (i == j) ? 1.f : 0.f;
#pragma unroll
            for (int k = 0; k < i; ++k) a -= Lb[i * 64 + k] * t[k];
            t[i] = a; if ((i & 3) == 3) asm volatile("" ::: "memory"); }
        asm volatile("s_waitcnt lgkmcnt(0)" ::: "memory");
#pragma unroll
        for (int i = 0; i < 16; ++i) Lf[(16 * g4 + i) * 64 + 16 * g4 + j] = t[i]; }
    __syncthreads();
#pragma unroll 1
    for (int I = 1; I < 4; ++I) { const int c = tid & 63, r = tid >> 6, n = 16 * I;
        if (c < n) { float a0 = 0.f, a1 = 0.f;
#pragma unroll 8
            for (int k = 0; k < n; ++k) { const float tm = Lf[k * 64 + c]; a0 -= Lf[(n + r) * 64 + k] * tm; a1 -= Lf[(n + r + 8) * 64 + k] * tm; }
            RTm[r * 64 + c] = a0; RTm[(r + 8) * 64 + c] = a1; }
        __syncthreads();
        if (c < n) { float b0 = 0.f, b1 = 0.f;
#pragma unroll
            for (int k = 0; k < 16; ++k) { const float rk = RTm[k * 64 + c]; b0 += Lf[(n + r) * 64 + n + k] * rk; b1 += Lf[(n + r + 8) * 64 + n + k] * rk; }
            Lf[(n + r) * 64 + c] = b0; Lf[(n + r + 8) * 64 + c] = b1; }
        __syncthreads(); }
    }
#pragma unroll 1
    for (int rep4 = 0; rep4 < ((PREP_REP & 4) ? 2 : 1); ++rep4) {
    __syncthreads();
    { const int c = tid >> 3, s0 = (tid & 7) * 8; float u[8], ww[8];
#pragma unroll
      for (int q = 0; q < 8; ++q) { const float t = Lf[c * 64 + s0 + q] * BE[s0 + q]; u[q] = t; ww[q] = t * EG[s0 + q]; }
      *(uint4*)(lds + O_TMU + c * RT_ + s0 * 2) = make_uint4(pk_bf16c(u[0], u[1]), pk_bf16c(u[2], u[3]), pk_bf16c(u[4], u[5]), pk_bf16c(u[6], u[7]));
      *(uint4*)(lds + O_TMW + c * RT_ + s0 * 2) = make_uint4(pk_bf16c(ww[0], ww[1]), pk_bf16c(ww[2], ww[3]), pk_bf16c(ww[4], ww[5]), pk_bf16c(ww[6], ww[7])); }
    __syncthreads();
    { f32x16 z;
#pragma unroll
      for (int i = 0; i < 16; ++i) z[i] = 0.f;
      const f32x16 ut = mm32<4>(z, lds + O_VT + (w >> 1) * 32 * RT_, RT_, lds + O_TMU + (w & 1) * 32 * RT_, RT_, lane);
      *(uint4*)(ga + tid * 32) = make_uint4(pk_bf16c(ut[0], ut[1]), pk_bf16c(ut[2], ut[3]), pk_bf16c(ut[4], ut[5]), pk_bf16c(ut[6], ut[7]));
      *(uint4*)(ga + tid * 32 + 16) = make_uint4(pk_bf16c(ut[8], ut[9]), pk_bf16c(ut[10], ut[11]), pk_bf16c(ut[12], ut[13]), pk_bf16c(ut[14], ut[15]));
      const f32x16 wa = mm32<4>(z, lds + O_TMW + (w >> 2) * 32 * RT_, RT_, lds + O_KT + (w & 3) * 32 * RT_, RT_, lane);
      unsigned char* wb = lds + O_W + ((w >> 2) * 32 + 4 * hi) * RK + ((w & 3) * 32 + l31) * 2;
#pragma unroll
      for (int i = 0; i < 16; ++i) *(unsigned short*)(wb + CRC(i) * RK) = f2bf(wa[i]); }
    __syncthreads();
#pragma unroll
    for (int i = 0; i < 2; ++i) { const int pc = tid + i * 512; *(uint4*)(ga + 16384 + pc * 16) = *(const uint4*)(lds + O_W + (pc >> 4) * RK + (pc & 15) * 16); }
    }
}
__device__ __forceinline__ uint4 ldc16(const unsigned char* p) {
    const unsigned long long a = __hip_atomic_load((const unsigned long long*)p, __ATOMIC_RELAXED, __HIP_MEMORY_SCOPE_AGENT);
    const unsigned long long b = __hip_atomic_load((const unsigned long long*)p + 1, __ATOMIC_RELAXED, __HIP_MEMORY_SCOPE_AGENT);
    return make_uint4((unsigned)a, (unsigned)(a >> 32), (unsigned)b, (unsigned)(b >> 32)); }
constexpr int O_OB2 = 90112;
__device__ __forceinline__ void scan_epilogue(const Params& p, const unsigned char* lds, int b, int h, int t0, uint4 z0, uint4 z1, const float (&gg)[16]) {
    const int tid = threadIdx.x; const int s = tid >> 3, dg = tid & 7;
    const uint4 q0 = *(const uint4*)(lds + O_OB2 + s * RK + dg * 32), q1 = *(const uint4*)(lds + O_OB2 + s * RK + dg * 32 + 16);
    const unsigned qq[8] = {q0.x, q0.y, q0.z, q0.w, q1.x, q1.y, q1.z, q1.w};
    float o[16]; float ss = 0.f;
#pragma unroll
    for (int q = 0; q < 8; ++q) { o[2 * q] = __uint_as_float(qq[q] << 16); o[2 * q + 1] = __uint_as_float(qq[q] & 0xffff0000u); }
#pragma unroll
    for (int c = 0; c < 16; ++c) ss += o[c] * o[c];
    ss += __shfl_xor(ss, 1); ss += __shfl_xor(ss, 2); ss += __shfl_xor(ss, 4);
    const float rstd = __builtin_amdgcn_rsqf(ss * (1.0f / 128.0f) + 1e-6f);
    const size_t tok = (size_t)b * SEQ + t0 + s;
    const unsigned zz[8] = {z0.x, z0.y, z0.z, z0.w, z1.x, z1.y, z1.z, z1.w};
    unsigned ow[8];
#pragma unroll
    for (int q = 0; q < 8; ++q) { const float za = __uint_as_float(zz[q] << 16), zb = __uint_as_float(zz[q] & 0xffff0000u);
        const float sa = za * __builtin_amdgcn_rcpf(1.f + __builtin_amdgcn_exp2f(-1.4426950408889634f * za)), sb = zb * __builtin_amdgcn_rcpf(1.f + __builtin_amdgcn_exp2f(-1.4426950408889634f * zb));
        const float va = o[2 * q] * rstd * gg[2 * q] * sa, vb = o[2 * q + 1] * rstd * gg[2 * q + 1] * sb;
        ow[q] = pk_bf16(va, vb); }
    unsigned short* dst = (unsigned short*)(p.ws + WS_HB) + tok * 1024 + h * 128 + dg * 16;
    *(uint4*)dst = make_uint4(ow[0], ow[1], ow[2], ow[3]); *(uint4*)(dst + 8) = make_uint4(ow[4], ow[5], ow[6], ow[7]);
}
__device__ void scan_unit(const Params& p, unsigned char* lds, int bh) {
    const int tid = threadIdx.x, lane = tid & 63, w = tid >> 6, hi = lane >> 5, l31 = lane & 31, b = bh >> 2, h = bh & 3;
    const float* GC = (const float*)(lds + O_G); const float* EG = GC + 128; const float* DL = GC + 192;
    f32x16 Sacc[2];
#pragma unroll
    for (int i = 0; i < 16; ++i) { Sacc[0][i] = 0.f; Sacc[1][i] = 0.f; }
    for (int i = tid; i < 34816 / 16; i += 512) ((uint4*)(lds + O_ST))[i] = make_uint4(0u, 0u, 0u, 0u);
    uint4 rU0, rU1, rW0, rW1, rQ0, rQ1, rK0, rK1, rM, rG = make_uint4(0u, 0u, 0u, 0u), rZ0, rZ1;
    const int es = tid >> 3, edg = tid & 7;
#define SCAN_LOAD(chn) do { const unsigned char* ga_ = prepA(p, bh, (chn)); const unsigned char* gb_ = prepB(p, bh, (chn));                          \
        rU0 = *(const uint4*)(ga_ + tid * 32); rU1 = *(const uint4*)(ga_ + tid * 32 + 16);                                                           \
        rW0 = *(const uint4*)(ga_ + 16384 + tid * 16); rW1 = *(const uint4*)(ga_ + 16384 + (tid + 512) * 16);                                        \
        rQ0 = *(const uint4*)(ga_ + 32768 + tid * 16); rQ1 = *(const uint4*)(ga_ + 32768 + (tid + 512) * 16);                                        \
        rK0 = *(const uint4*)(ga_ + 49152 + tid * 16); rK1 = *(const uint4*)(ga_ + 49152 + (tid + 512) * 16);                                        \
        rM = *(const uint4*)(gb_ + tid * 16); if (tid < 32) rG = *(const uint4*)(gb_ + 8192 + tid * 16);                                             \
        { const unsigned short* zp_ = (const unsigned short*)(p.ws + WS_ZG) + ((size_t)b * SEQ + (chn) * 64 + es) * 3072 + h * 128 + edg * 16;       \
          rZ0 = *(const uint4*)zp_; rZ1 = *(const uint4*)(zp_ + 8); } } while (0)
    f32x16 ut; uint4 zc0, zc1, zp0 = make_uint4(0u, 0u, 0u, 0u), zp1 = zp0;
    float gg[16];
#pragma unroll
    for (int q = 0; q < 16; ++q) gg[q] = p.g_gdn_out[edg * 16 + q];
#define SCAN_FILL() do { const int p0_ = tid, p1_ = tid + 512;                                                                                       \
        { const unsigned uu_[8] = {rU0.x, rU0.y, rU0.z, rU0.w, rU1.x, rU1.y, rU1.z, rU1.w};                                                          \
          _Pragma("unroll") for (int q = 0; q < 8; ++q) { ut[2 * q] = __uint_as_float(uu_[q] << 16); ut[2 * q + 1] = __uint_as_float(uu_[q] & 0xffff0000u); } } \
        *(uint4*)(lds + O_W + (p0_ >> 4) * RK + (p0_ & 15) * 16) = rW0; *(uint4*)(lds + O_W + (p1_ >> 4) * RK + (p1_ & 15) * 16) = rW1;              \
        *(uint4*)(lds + O_QN + (p0_ >> 4) * RK + (p0_ & 15) * 16) = rQ0; *(uint4*)(lds + O_QN + (p1_ >> 4) * RK + (p1_ & 15) * 16) = rQ1;            \
        *(uint4*)(lds + O_KT + (p0_ >> 3) * RT_ + (p0_ & 7) * 16) = rK0; *(uint4*)(lds + O_KT + (p1_ >> 3) * RT_ + (p1_ & 7) * 16) = rK1;            \
        *(uint4*)(lds + O_QKM + (tid >> 3) * RT_ + (tid & 7) * 16) = rM;                                                                             \
        if (tid < 32) *(uint4*)(lds + O_G + 512 + tid * 16) = rG;                                                                                    \
        zc0 = rZ0; zc1 = rZ1; } while (0)
    SCAN_LOAD(0);
    SCAN_FILL();
    SCAN_LOAD(1);
    __syncthreads();
#pragma unroll 1
    for (int ch = 0; ch < SEQ / 64; ++ch) {
        if (ch > 0) scan_epilogue(p, lds, b, h, (ch - 1) * 64, zp0, zp1, gg);
        f32x16 oacc;
        { f32x16 z;
#pragma unroll
          for (int i = 0; i < 16; ++i) z[i] = 0.f;
          const f32x16 acc = mm32<8>(z, lds + O_ST + (w >> 1) * 32 * RK, RK, lds + O_W + (w & 1) * 32 * RK, RK, lane);
          const int c = (w & 1) * 32 + l31; const float dl = DL[c]; unsigned char* vb_ = lds + O_VNT + ((w >> 1) * 32 + 4 * hi) * RT_ + c * 2;
#pragma unroll
          for (int i = 0; i < 16; ++i) { const float vn = ut[i] - acc[i];
              *(unsigned short*)(vb_ + CRC(i) * RT_) = f2bf(vn); *(unsigned short*)(vb_ + (O_VNTD - O_VNT) + CRC(i) * RT_) = f2bf(vn * dl); }
          oacc = mm32<8>(z, lds + O_QN + (w >> 2) * 32 * RK, RK, lds + O_ST + (w & 3) * 32 * RK, RK, lane);
          { const float* egb = EG + (w >> 2) * 32 + 4 * hi;
#pragma unroll
            for (int i = 0; i < 16; ++i) oacc[i] *= egb[CRC(i)]; }
          const float gam = EG[63];
#pragma unroll
          for (int j = 0; j < 2; ++j)
#pragma unroll
              for (int i = 0; i < 16; ++i) Sacc[j][i] *= gam; }
        __syncthreads();
        oacc = mm32<4>(oacc, lds + O_QKM + (w >> 2) * 32 * RT_, RT_, lds + O_VNT + (w & 3) * 32 * RT_, RT_, lane);
#pragma unroll
        for (int j = 0; j < 2; ++j) Sacc[j] = mm32<4>(Sacc[j], lds + O_VNTD + (w >> 1) * 32 * RT_, RT_, lds + O_KT + ((w & 1) * 2 + j) * 32 * RT_, RT_, lane);
        __syncthreads();
#pragma unroll
        for (int j = 0; j < 2; ++j) { unsigned char* sb_ = lds + O_ST + ((w >> 1) * 32 + 4 * hi) * RK + (((w & 1) * 2 + j) * 32 + l31) * 2;
#pragma unroll
            for (int i = 0; i < 16; ++i) *(unsigned short*)(sb_ + CRC(i) * RK) = f2bf(Sacc[j][i]); }
        { unsigned char* ob_ = lds + O_OB2 + ((w >> 2) * 32 + 4 * hi) * RK + ((w & 3) * 32 + l31) * 2;
#pragma unroll
          for (int i = 0; i < 16; ++i) *(unsigned short*)(ob_ + CRC(i) * RK) = f2bf(oacc[i]); }
        zp0 = zc0; zp1 = zc1;
        if (ch + 1 < SEQ / 64) { SCAN_FILL(); if (ch + 2 < SEQ / 64) SCAN_LOAD(ch + 2); }
        __syncthreads();
    }
    scan_epilogue(p, lds, b, h, (SEQ / 64 - 1) * 64, zp0, zp1, gg);
    __syncthreads();
#undef SCAN_LOAD
#undef SCAN_FILL
}
}

__device__ __forceinline__ void attn_phase(const Params& p, unsigned char* lds8, int rep) {
    using namespace fox;
    typedef BlockRef<bf16, bf16> Ref;
    char* lds = (char*)lds8;
    volatile int* slot = (volatile int*)(lds + SLOT_OFF);
    unsigned* ctr = (unsigned*)(p.ws + WS_CTRL) + rep;
    const int total = NBATCH * NHEAD * (SEQ / QB);
    const bf16* FQ = (const bf16*)(p.ws + WS_FQKV); const bf16* FK = FQ + (size_t)MTOK * 512; const bf16* FV = FK + (size_t)MTOK * 512;
    auto mkref = [&](int L) { Ref r; const int qb = (SEQ / QB - 1) - (L >> 5), bh = L & 31, b = bh >> 2, h = bh & 3;
        r.Q = FQ + ((size_t)bh * SEQ + (size_t)qb * QB) * D; r.K = FK + (size_t)bh * SEQ * D; r.V = FV + (size_t)bh * SEQ * D;
        r.KB = (const float*)(p.ws + WS_KBIAS) + (size_t)bh * SEQ;
        r.O = (bf16*)(p.ws + WS_HB) + ((size_t)b * SEQ + (size_t)qb * QB) * OSTR + 512 + h * 128;
        r.Z = (const unsigned short*)(p.ws + WS_ZG) + ((size_t)b * SEQ + (size_t)qb * QB) * ZSTR + 512 + h * 128;
        r.P0 = qb * QB; return r; };
    int it = 0;
    __syncthreads();
    if (threadIdx.x == 0) slot[0] = (int)atomicAdd(ctr, 1u);
    __syncthreads();
    int L = __builtin_amdgcn_readfirstlane(slot[0]);
    if (L >= total) return;
    Ref cur = mkref(L);
    Seam<bf16> S;
    causal_swa_prime<bf16, bf16>(cur, 1 << 20, lds, S);
    for (;;) {
        ++it;
        if (threadIdx.x == 0) slot[it & 1] = (int)atomicAdd(ctr, 1u);
        __syncthreads();
        const int Ln = __builtin_amdgcn_readfirstlane(slot[it & 1]);
        const bool last = Ln >= total;
        const Ref nxt = last ? cur : mkref(Ln);
        causal_swa_block<bf16, bf16>(cur, nxt, SEQ, 1 << 20, lds, S);
        if (last) break;
        cur = nxt;
    }
    __syncthreads();
}

__device__ __forceinline__ void run_p2(const Params& p, unsigned char* lds) {
    phase_cumsum(p, lds);
    __syncthreads();
    pg8::Gemm g{(const pg8::bf16_t*)(p.ws + WS_HB), (const pg8::bf16_t*)(p.ws + WS_WIN_T), MTOK, NPROJ, 1024, 1024, 1024};
    pg8::StaticOrder S; S.init(MTOK, NPROJ, gridDim.x, blockIdx.x);
    pg8::EpiProj E{(pg8::bf16_t*)(p.ws + WS_GQKV), (pg8::bf16_t*)(p.ws + WS_FQKV), (pg8::bf16_t*)(p.ws + WS_ZG), p.g_q_fox, p.g_k_fox, (PG8_LAS float*)((PG8_LAS unsigned char*)lds + GEMM_X_OFF)};
    pg8::gemm_phase<pg8::EpiProj, pg8::StaticOrder, true, true>((PG8_LAS unsigned char*)lds, g, S, E);
}
__device__ __forceinline__ void run_p3a(const Params& p, unsigned char* lds) {
    { const int h0 = blockIdx.x & 3; float* cw = (float*)(lds + gdn2::O_CW);
      for (int i = threadIdx.x; i < 1536; i += 512) { const int pt = i >> 7, d = i & 127, part = pt >> 2, tap = pt & 3; cw[i] = p.conv_w[tap * 1536 + part * 512 + h0 * 128 + d]; } }
    gdn2::RawRegs R; { const int L0 = blockIdx.x; if (L0 < 4096) gdn2::stage_load(p, R, (L0 & 31) >> 2, L0 & 3, (L0 >> 5) * 64); }
#pragma unroll 1
    for (int L = blockIdx.x; L < 4096; L += gridDim.x) { const int Ln = L + gridDim.x; gdn2::prep_unit(p, lds, L & 31, L >> 5, R, Ln < 4096, Ln & 31, Ln >> 5); }
    __syncthreads();
}
__device__ __forceinline__ void run_p3(const Params& p, unsigned char* lds, int rep) {
    if (PH_MASK & 64) { if (blockIdx.x < 32) { gdn2::scan_unit(p, lds, blockIdx.x); if (PREP_REP & 8) gdn2::scan_unit(p, lds, blockIdx.x); } }
    if (PH_MASK & 8) attn_phase(p, lds, rep);
}
__device__ __forceinline__ void run_p4(const Params& p, unsigned char* lds) {
    pg8::Gemm g{(const pg8::bf16_t*)(p.ws + WS_HB), (const pg8::bf16_t*)(p.ws + WS_WO2_T), MTOK, 1024, 1024, 1024, 1024};
    pg8::StaticOrder S; S.init(MTOK, 1024, gridDim.x, blockIdx.x);
    pg8::EpiMerge E{(pg8::bf16_t*)(p.ws + WS_FQKV), (const pg8::bf16_t*)(p.ws + WS_ZG) + 1024};
    pg8::gemm_phase<pg8::EpiMerge, pg8::StaticOrder, true, true>((PG8_LAS unsigned char*)lds, g, S, E);
}
__device__ __forceinline__ void run_p5(const Params& p, unsigned char* lds) {
    pg8::Gemm g{(const pg8::bf16_t*)(p.ws + WS_FQKV), (const pg8::bf16_t*)(p.ws + WS_WOUT2_T), MTOK, 1024, 1024, 1024, 2048};
    pg8::StaticOrder S; S.init(MTOK, 1024, gridDim.x, blockIdx.x);
    pg8::EpiOut E{p.x, p.out, (const float*)(p.ws + WS_MOD)};
    pg8::gemm_phase<pg8::EpiOut, pg8::StaticOrder, true, true>((PG8_LAS unsigned char*)lds, g, S, E);
}

__global__ void __launch_bounds__(512, 2) fwd_kernel(Params p, int ph_lo, int ph_hi) {
    extern __shared__ __attribute__((aligned(16))) unsigned char lds[];
    cg::grid_group grid = cg::this_grid();
#define GSYNC() do { grid.sync(); } while (0)
#define IN(ph) (ph_lo <= (ph) && (ph) < ph_hi)
#define SEAM(ph) do { if (IN(ph) && (ph) + 1 < ph_hi) GSYNC(); } while (0)
    if (IN(0)) { if (PH_MASK & 1) phase_prologue(p, lds); }
#if REPEAT_PH == 0
    GSYNC(); phase_prologue(p, lds);
#endif
    SEAM(0);
    if (IN(1)) { if (PH_MASK & 2) phase_prepass(p, lds); }
#if REPEAT_PH == 1
    GSYNC(); phase_prepass(p, lds);
#endif
    SEAM(1);
    if (IN(2) && (PH_MASK & 4)) run_p2(p, lds);
#if REPEAT_PH == 2
    GSYNC(); run_p2(p, lds);
#endif
    SEAM(2);
    if (IN(3)) { run_p3a(p, lds); GSYNC(); run_p3(p, lds, 0); }
#if REPEAT_PH == 3
    GSYNC(); run_p3(p, lds, 1);
#endif
#if REPEAT_PH == 6
    GSYNC(); run_p3a(p, lds);
#endif
    SEAM(3);
    if (IN(4) && (PH_MASK & 16)) run_p4(p, lds);
#if REPEAT_PH == 4
    GSYNC(); run_p4(p, lds);
#endif
    SEAM(4);
    if (IN(5) && (PH_MASK & 32)) run_p5(p, lds);
#if REPEAT_PH == 5
    GSYNC(); run_p5(p, lds);
#endif
}

extern "C" void kernel_launch(void* const* d_in, const int* in_sizes, int n_in, void* d_out, int out_size, void* d_ws, size_t ws_size, hipStream_t stream) {
    static int grid_blocks = 0;
    if (grid_blocks == 0) {
        if (n_in != 16 || out_size != MTOK * DM || ws_size < WS_END) { fprintf(stderr, "kernel_launch: unexpected shapes (n_in %d out %d ws %zu need %zu)\n", n_in, out_size, ws_size, (size_t)WS_END); grid_blocks = -1; return; }
        int dev = 0, cus = 0, per_cu = 0;
        (void)hipGetDevice(&dev); (void)hipDeviceGetAttribute(&cus, hipDeviceAttributeMultiprocessorCount, dev);
        if (hipFuncSetAttribute((const void*)fwd_kernel, hipFuncAttributeMaxDynamicSharedMemorySize, LDS_TOTAL) != hipSuccess) fprintf(stderr, "kernel_launch: hipFuncSetAttribute failed\n");
        if (hipOccupancyMaxActiveBlocksPerMultiprocessor(&per_cu, (const void*)fwd_kernel, 512, LDS_TOTAL) != hipSuccess || per_cu < 1) { fprintf(stderr, "kernel_launch: occupancy query says %d\n", per_cu); per_cu = 1; }
        (void)hipGetLastError();
        grid_blocks = cus - cus % 32;
        if (grid_blocks <= 0) grid_blocks = 256;
    }
    if (grid_blocks < 0) return;
    Params p{};
    p.x = (const float*)d_in[0]; p.c = (const float*)d_in[1]; p.w_ada = (const float*)d_in[2]; p.b_ada = (const float*)d_in[3]; p.g_norm = (const float*)d_in[4]; p.w_in = (const float*)d_in[5];
    p.conv_w = (const float*)d_in[6]; p.A_log = (const float*)d_in[7]; p.dt_bias = (const float*)d_in[8]; p.g_gdn_out = (const float*)d_in[9]; p.g_q_fox = (const float*)d_in[10]; p.g_k_fox = (const float*)d_in[11];
    p.b_f = (const float*)d_in[12]; p.w_o_gdn = (const float*)d_in[13]; p.w_o_fox = (const float*)d_in[14]; p.w_out = (const float*)d_in[15];
    p.out = (float*)d_out; p.ws = (unsigned char*)d_ws;
#ifdef MULTI_LAUNCH
    for (int ph = 0; ph < 6; ++ph) { int lo = ph, hi = ph + 1; void* args[] = {&p, &lo, &hi};
        hipError_t e = hipLaunchCooperativeKernel((const void*)fwd_kernel, dim3(grid_blocks), dim3(512), args, LDS_TOTAL, stream);
        if (e != hipSuccess) fprintf(stderr, "launch %d failed: %s\n", ph, hipGetErrorString(e)); }
#else
    int lo = 0, hi = 6; void* args[] = {&p, &lo, &hi};
    hipError_t e = hipLaunchCooperativeKernel((const void*)fwd_kernel, dim3(grid_blocks), dim3(512), args, LDS_TOTAL, stream);
    if (e != hipSuccess) fprintf(stderr, "cooperative launch failed: %s (grid %d)\n", hipGetErrorString(e), grid_blocks);
#endif
}
```

```cpp
#include <hip/hip_runtime.h>
#include <hip/hip_bf16.h>
#include <hip/hip_cooperative_groups.h>
#include <cstdio>
#include <cstdint>
namespace cg = cooperative_groups;
#ifndef REPEAT_PH
#define REPEAT_PH -1
#endif
#ifndef PH_MASK
#define PH_MASK 127
#endif

constexpr int NBATCH = 8, SEQ = 8192, DM = 1024, MTOK = NBATCH * SEQ, NHEAD = 4, HDIM = 128;
constexpr int DIN = 6156, NPROJ = 6144;
constexpr size_t WS_CTRL = 0;
constexpr size_t WS_MOD = 4096;
constexpr size_t WS_WSMALL = WS_MOD + (size_t)NBATCH * 3072 * 4;
constexpr size_t WS_WIN_T = WS_WSMALL + 12 * 1024 * 4;
constexpr size_t WS_WO2_T = WS_WIN_T + (size_t)NPROJ * 1024 * 2;
constexpr size_t WS_WOUT2_T = WS_WO2_T + (size_t)2048 * 512 * 2;
constexpr size_t WS_GDEC = WS_WOUT2_T + (size_t)1024 * 2048 * 2;
constexpr size_t WS_BETA = WS_GDEC + (size_t)MTOK * 16;
constexpr size_t WS_LOGF = WS_BETA + (size_t)MTOK * 16;
constexpr size_t WS_KBIAS = WS_LOGF + (size_t)MTOK * 16;
constexpr size_t WS_HB = WS_KBIAS + (size_t)MTOK * 16;
constexpr size_t WS_GQKV = WS_HB + (size_t)MTOK * 1024 * 2;
constexpr size_t WS_FQKV = WS_GQKV + (size_t)MTOK * 1536 * 2;
constexpr size_t WS_ZG = WS_FQKV + (size_t)3 * MTOK * 512 * 2;
constexpr size_t WS_PREPB = WS_ZG + (size_t)MTOK * 3072 * 2;
constexpr size_t WS_JLO = WS_PREPB + (size_t)4096 * 8704;
constexpr size_t WS_END = WS_JLO + 4096;
static_assert(WS_WIN_T % 256 == 0 && WS_HB % 256 == 0 && WS_ZG % 256 == 0, "align");

struct Params {
    const float* x; const float* c; const float* w_ada; const float* b_ada; const float* g_norm; const float* w_in;
    const float* conv_w; const float* A_log; const float* dt_bias; const float* g_gdn_out; const float* g_q_fox; const float* g_k_fox;
    const float* b_f; const float* w_o_gdn; const float* w_o_fox; const float* w_out;
    float* out; unsigned char* ws;
};

__device__ __forceinline__ float bf2f(unsigned short u) { return __uint_as_float((unsigned)u << 16); }
typedef __bf16 bf16v2_t __attribute__((ext_vector_type(2)));
typedef float f32v2_t __attribute__((ext_vector_type(2)));
__device__ __forceinline__ unsigned pk_bf16(float lo, float hi) { unsigned r; asm volatile("v_cvt_pk_bf16_f32 %0, %1, %2" : "=v"(r) : "v"(lo), "v"(hi)); return r; }
__device__ __forceinline__ unsigned pk_bf16c(float lo, float hi) { const bf16v2_t r = __builtin_convertvector((f32v2_t){lo, hi}, bf16v2_t); return __builtin_bit_cast(unsigned, r); }
__device__ __forceinline__ float sigmoidf_(float v) { return 1.f / (1.f + __expf(-v)); }
__device__ __forceinline__ float siluf_(float v) { return v / (1.f + __expf(-v)); }
__device__ __forceinline__ float softplusf_(float v) { return fmaxf(v, 0.f) + log1pf(__expf(-fabsf(v))); }
#define WG_BARRIER() do { asm volatile("s_waitcnt vmcnt(0) lgkmcnt(0)" ::: "memory"); __builtin_amdgcn_s_barrier(); asm volatile("" ::: "memory"); } while (0)

namespace pg8 {
#define PG8_LAS __attribute__((address_space(3)))
typedef unsigned short bf16_t;
typedef short bf16x8 __attribute__((ext_vector_type(8)));
typedef float f32x4 __attribute__((ext_vector_type(4)));
typedef unsigned u32x4 __attribute__((ext_vector_type(4)));
constexpr int BM = 256, BK = 64, HALF = 128, HTB = HALF * BK * 2  , STAGE_BYTES = 8 * HTB, NXCD = 8, WGM = 8;

__host__ __device__ __forceinline__ int lds_byte(int r, int c) { const int st = (r >> 4) * 2 + (c >> 5), rr = r & 15, cc = c & 31, ob = rr * 64 + cc * 2; return st * 1024 + (ob ^ (((ob >> 9) & 1) << 5)); }
__host__ __device__ __forceinline__ void stage_rc(int b, int& R, int& C) { const int st = b / 1024, sb = b % 1024, swz = sb ^ (((sb >> 9) & 1) << 5); R = (st >> 1) * 16 + swz / 64; C = (st & 1) * 32 + (swz % 64) / 2; }
__host__ __device__ __forceinline__ int perm32(int rho) { const int n = rho >> 4, i = rho & 15; return 8 * (i >> 2) + 4 * n + (i & 3); }

struct Unit { int pm, pn; };
struct Gemm { const bf16_t* A; const bf16_t* Bt; int M, N, K, lda, ldb; };

struct StaticOrder {
    int nM, nN, nwg, G, c;
    __host__ __device__ void init(int M, int N, int G_, int c_) { nM = M / BM; nN = N / BM; nwg = nM * nN; G = G_; c = c_; }
    __host__ __device__ bool next(int i, Unit& u) const {
        const long L = (long)i * G + c; if (L >= nwg) return false;
        int wgid = (int)L; { const int q = nwg / NXCD, r = nwg % NXCD, xcd = wgid % NXCD, off = wgid / NXCD; wgid = (xcd < r ? xcd * (q + 1) : r * (q + 1) + (xcd - r) * q) + off; }
        const int nig = WGM * nN, gid = wgid / nig, fm = gid * WGM, gsz = (nM - fm) < WGM ? (nM - fm) : WGM;
        u.pm = fm + ((wgid % nig) % gsz); u.pn = (wgid % nig) / gsz; return true;
    }
    __device__ __forceinline__ void a_ready(const Unit&) const {}
    __device__ __forceinline__ void done(const Unit&) const {}
};

typedef unsigned u32x4 __attribute__((ext_vector_type(4)));
__device__ __forceinline__ u32x4 pack8bf(const f32x4 v0, const f32x4 v1) { u32x4 w; w.x = pk_bf16(v0[0], v0[1]); w.y = pk_bf16(v0[2], v0[3]); w.z = pk_bf16(v1[0], v1[1]); w.w = pk_bf16(v1[2], v1[3]); return w; }
struct EpiProj {
    static constexpr bool PERM = true, AFTER_DRAIN = false, MIDHOOK = false;
    bf16_t* gqkv; bf16_t* fqkv; bf16_t* zg; const float* gq; const float* gk; PG8_LAS float* X;
    __device__ __forceinline__ void operator()(const f32x4 (&acc)[2][2][4][2], const Unit& u, int wr, int wc, int fr, int fq) const {
        const int pn = u.pn, row0 = u.pm * BM + wr * 64 + fr, cl = wc * 32 + 8 * fq;
        const bool nrm = pn >= 8 && pn < 12;
        if (nrm) {
#pragma unroll
            for (int ai = 0; ai < 2; ++ai)
#pragma unroll
                for (int m = 0; m < 4; ++m)
#pragma unroll
                    for (int bj = 0; bj < 2; ++bj) { const f32x4 a = acc[ai][bj][m][0], b = acc[ai][bj][m][1];
                        float s = (a[0] * a[0] + a[1] * a[1]) + (a[2] * a[2] + a[3] * a[3]) + (b[0] * b[0] + b[1] * b[1]) + (b[2] * b[2] + b[3] * b[3]);
                        s += __shfl_xor(s, 16); s += __shfl_xor(s, 32);
                        if (fq == 0) X[((ai * HALF + wr * 64 + m * 16 + fr) * 2 + bj) * 4 + wc] = s; asm volatile("" ::: "memory"); }
            asm volatile("s_waitcnt lgkmcnt(0)" ::: "memory"); __builtin_amdgcn_s_barrier(); asm volatile("" ::: "memory");
        }
        bf16_t* base; size_t bstride, bjstride; int ld;
        if (pn >= 8 && pn < 14) { base = fqkv + (size_t)((pn - 8) >> 1) * ((size_t)MTOK * 512) + (size_t)((pn & 1) * 2) * SEQ * 128 + cl; bstride = (size_t)4 * SEQ * 128; bjstride = (size_t)SEQ * 128; ld = 128; }
        else if (pn < 6) { base = gqkv + pn * 256 + cl; bstride = (size_t)SEQ * 1536; bjstride = 128; ld = 1536; }
        else { const int c0 = pn < 8 ? (pn - 6) * 256 : (pn < 16 ? 512 + (pn - 14) * 256 : 1024 + (pn - 16) * 256); base = zg + c0 + cl; bstride = (size_t)SEQ * 3072; bjstride = 128; ld = 3072; }
        const float* gv = (pn < 10) ? gq : gk;
        base += (size_t)((u.pm * BM) >> 13) * bstride;
        const int t0 = (row0 & 8191);
#pragma unroll
        for (int ai = 0; ai < 2; ++ai)
#pragma unroll
            for (int m = 0; m < 4; ++m) { bf16_t* rowp = base + (size_t)(t0 + ai * HALF + m * 16) * ld;
#pragma unroll
                for (int bj = 0; bj < 2; ++bj) { float r = 1.f; f32x4 g0 = {1.f, 1.f, 1.f, 1.f}, g1 = {1.f, 1.f, 1.f, 1.f};
                    if (nrm) { g0 = *(const f32x4*)(gv + cl); g1 = *(const f32x4*)(gv + cl + 4); const f32x4 t4 = *(const PG8_LAS f32x4*)(X + ((ai * HALF + wr * 64 + m * 16 + fr) * 2 + bj) * 4); r = 1.0f / sqrtf(((t4[0] + t4[1]) + (t4[2] + t4[3])) * (1.0f / 128.0f) + 1e-6f); }
                    *(u32x4*)(rowp + bj * bjstride) = pack8bf(acc[ai][bj][m][0] * (g0 * r), acc[ai][bj][m][1] * (g1 * r)); }
                asm volatile("" ::: "memory"); }
    }
};
struct EpiGate {
    static constexpr bool PERM = true, AFTER_DRAIN = false, MIDHOOK = false;
    bf16_t* G; const bf16_t* gate; int add;
    __device__ __forceinline__ void operator()(const f32x4 (&acc)[2][2][4][2], const Unit& u, int wr, int wc, int fr, int fq) const {
        const int row0 = u.pm * BM + wr * 64 + fr, col0 = u.pn * BM + wc * 32 + 8 * fq;
#pragma unroll
        for (int ai = 0; ai < 2; ++ai)
#pragma unroll
            for (int m = 0; m < 4; ++m) { const size_t gr = (size_t)(row0 + ai * HALF + m * 16);
#pragma unroll
                for (int bj = 0; bj < 2; ++bj) { const u32x4 gw = *(const u32x4*)(gate + gr * 3072 + col0 + bj * HALF);
                    f32x4 s0, s1;
                    s0[0] = __uint_as_float(gw.x << 16); s0[1] = __uint_as_float(gw.x & 0xffff0000u); s0[2] = __uint_as_float(gw.y << 16); s0[3] = __uint_as_float(gw.y & 0xffff0000u);
                    s1[0] = __uint_as_float(gw.z << 16); s1[1] = __uint_as_float(gw.z & 0xffff0000u); s1[2] = __uint_as_float(gw.w << 16); s1[3] = __uint_as_float(gw.w & 0xffff0000u);
#pragma unroll
                    for (int i = 0; i < 4; ++i) { s0[i] = __builtin_amdgcn_rcpf(1.f + __builtin_amdgcn_exp2f(-1.4426950408889634f * s0[i])); s1[i] = __builtin_amdgcn_rcpf(1.f + __builtin_amdgcn_exp2f(-1.4426950408889634f * s1[i])); }
                    f32x4 v0 = acc[ai][bj][m][0] * s0, v1 = acc[ai][bj][m][1] * s1;
                    bf16_t* dst = G + gr * 1024 + col0 + bj * HALF;
                    if (add) { const u32x4 pw = *(const u32x4*)dst;
                        v0[0] += __uint_as_float(pw.x << 16); v0[1] += __uint_as_float(pw.x & 0xffff0000u); v0[2] += __uint_as_float(pw.y << 16); v0[3] += __uint_as_float(pw.y & 0xffff0000u);
                        v1[0] += __uint_as_float(pw.z << 16); v1[1] += __uint_as_float(pw.z & 0xffff0000u); v1[2] += __uint_as_float(pw.w << 16); v1[3] += __uint_as_float(pw.w & 0xffff0000u); }
                    *(u32x4*)dst = pack8bf(v0, v1); }
                if (m == 3) asm volatile("" ::: "memory"); }
    }
};
struct EpiMerge {
    static constexpr bool PERM = true, AFTER_DRAIN = false, MIDHOOK = true;
    bf16_t* G; const bf16_t* gate;
    __device__ __forceinline__ static void unpack8(const u32x4 gw, f32x4& s0, f32x4& s1) {
        s0[0] = __uint_as_float(gw.x << 16); s0[1] = __uint_as_float(gw.x & 0xffff0000u); s0[2] = __uint_as_float(gw.y << 16); s0[3] = __uint_as_float(gw.y & 0xffff0000u);
        s1[0] = __uint_as_float(gw.z << 16); s1[1] = __uint_as_float(gw.z & 0xffff0000u); s1[2] = __uint_as_float(gw.w << 16); s1[3] = __uint_as_float(gw.w & 0xffff0000u); }
    __device__ __forceinline__ void mid(f32x4 (&acc)[2][2][4][2], const Unit& u, int wr, int wc, int fr, int fq) const {
        const bf16_t* gp = gate + (size_t)(u.pm * BM + wr * 64 + fr) * 3072 + (u.pn * BM + wc * 32 + 8 * fq);
        asm volatile("" : "+v"(gp));
#pragma unroll
        for (int ai = 0; ai < 2; ++ai)
#pragma unroll
            for (int m = 0; m < 4; ++m) { const bf16_t* rp = gp + (size_t)(ai * HALF + m * 16) * 3072;
#pragma unroll
                for (int bj = 0; bj < 2; ++bj) { f32x4 a0, a1, f0, f1;
                    unpack8(*(const u32x4*)(rp + bj * HALF), a0, a1); unpack8(*(const u32x4*)(rp + 1024 + bj * HALF), f0, f1);
#pragma unroll
                    for (int i = 0; i < 4; ++i) {
                        a0[i] = (1.f + __builtin_amdgcn_exp2f(-1.4426950408889634f * f0[i])) * __builtin_amdgcn_rcpf(1.f + __builtin_amdgcn_exp2f(-1.4426950408889634f * a0[i]));
                        a1[i] = (1.f + __builtin_amdgcn_exp2f(-1.4426950408889634f * f1[i])) * __builtin_amdgcn_rcpf(1.f + __builtin_amdgcn_exp2f(-1.4426950408889634f * a1[i])); }
                    acc[ai][bj][m][0] *= a0; acc[ai][bj][m][1] *= a1; }
                asm volatile("" ::: "memory"); }
    }
    __device__ __forceinline__ void operator()(const f32x4 (&acc)[2][2][4][2], const Unit& u, int wr, int wc, int fr, int fq) const {
        const int row0 = u.pm * BM + wr * 64 + fr, col0 = u.pn * BM + wc * 32 + 8 * fq;
#pragma unroll
        for (int ai = 0; ai < 2; ++ai)
#pragma unroll
            for (int m = 0; m < 4; ++m) { const size_t gr = (size_t)(row0 + ai * HALF + m * 16);
#pragma unroll
                for (int bj = 0; bj < 2; ++bj) { f32x4 s0, s1; unpack8(*(const u32x4*)(gate + gr * 3072 + 1024 + col0 + bj * HALF), s0, s1);
#pragma unroll
                    for (int i = 0; i < 4; ++i) { s0[i] = __builtin_amdgcn_rcpf(1.f + __builtin_amdgcn_exp2f(-1.4426950408889634f * s0[i])); s1[i] = __builtin_amdgcn_rcpf(1.f + __builtin_amdgcn_exp2f(-1.4426950408889634f * s1[i])); }
                    *(u32x4*)(G + gr * 1024 + col0 + bj * HALF) = pack8bf(acc[ai][bj][m][0] * s0, acc[ai][bj][m][1] * s1); }
                if (m & 1) asm volatile("" ::: "memory"); }
    }
};
struct EpiOut {
    static constexpr bool PERM = true, AFTER_DRAIN = false, MIDHOOK = false;
    const float* x; float* out; const float* mod;
    __device__ __forceinline__ void operator()(const f32x4 (&acc)[2][2][4][2], const Unit& u, int wr, int wc, int fr, int fq) const {
        const int row0 = u.pm * BM + wr * 64 + fr, col0 = u.pn * BM + wc * 32 + 8 * fq;
        const float* gp = mod + (size_t)((u.pm * BM) >> 13) * 3072 + 2048 + col0;
        f32x4 gt[2][2];
#pragma unroll
        for (int bj = 0; bj < 2; ++bj) { gt[bj][0] = *(const f32x4*)(gp + bj * HALF); gt[bj][1] = *(const f32x4*)(gp + bj * HALF + 4); }
#pragma unroll
        for (int ai = 0; ai < 2; ++ai)
#pragma unroll
            for (int m = 0; m < 4; ++m) { const size_t off = (size_t)(row0 + ai * HALF + m * 16) * DM + col0;
#pragma unroll
                for (int bj = 0; bj < 2; ++bj) { const f32x4 x0 = *(const f32x4*)(x + off + bj * HALF), x1 = *(const f32x4*)(x + off + bj * HALF + 4);
                    *(f32x4*)(out + off + bj * HALF) = x0 + gt[bj][0] * acc[ai][bj][m][0]; *(f32x4*)(out + off + bj * HALF + 4) = x1 + gt[bj][1] * acc[ai][bj][m][1]; } }
    }
};

template <class Epi, class Sched, bool ALIGN_EPI = false, bool SP2 = false>
__device__ __forceinline__ void gemm_phase(PG8_LAS unsigned char* lds, const Gemm g, const Sched& S, const Epi& E) {
    const int tid = threadIdx.x, wid = __builtin_amdgcn_readfirstlane(tid >> 6), lane = tid & 63, wr = wid >> 2, wc = wid & 3, fr = lane & 15, fq = lane >> 4;
    const int K = g.K, nt = K / BK;
    unsigned voffA[2], voffB[2];
#pragma unroll
    for (int i = 0; i < 2; ++i) { int R, C; stage_rc(tid * 16 + i * 8192, R, C); const int Rb = Epi::PERM ? ((R & ~31) + perm32(R & 31)) : R;
        voffA[i] = (unsigned)(R * g.lda + C) * 2u; voffB[i] = (unsigned)(Rb * g.ldb + C) * 2u; }
    const size_t kstep = (size_t)(BK * 2);
    const size_t hstepA = (size_t)HALF * g.lda * 2, hstepB = (size_t)HALF * g.ldb * 2;
    const size_t tstepA = 2 * hstepA, tstepB = 2 * hstepB;
    const unsigned ldsw = (unsigned)wid * 1024u;
    const int aoff = lds_byte(wr * 64 + fr, fq * 8), boff = lds_byte(wc * 32 + fr, fq * 8);
#define PG8_SA(b, h) (((b) * 2 + (h)) * HTB)
#define PG8_SB(b, h) ((4 + (b) * 2 + (h)) * HTB)
#define PG8_STAGE(bufoff, gbase, voff) do { _Pragma("unroll") for (int _i = 0; _i < 2; ++_i) \
        __builtin_amdgcn_global_load_lds((const unsigned*)((const char*)(gbase) + (voff)[_i]), (PG8_LAS unsigned*)(lds + (bufoff) + ldsw + _i * 8192), 16, 0, 0); } while (0)
#define PG8_LDA(dst, b, h) do { _Pragma("unroll") for (int m = 0; m < 4; ++m) _Pragma("unroll") for (int k = 0; k < 2; ++k) dst[m][k] = *(const PG8_LAS bf16x8*)(lds + PG8_SA(b, h) + aoff + m * 2048 + k * 1024); } while (0)
#define PG8_LDB(dst, b, h) do { _Pragma("unroll") for (int n = 0; n < 2; ++n) _Pragma("unroll") for (int k = 0; k < 2; ++k) dst[n][k] = *(const PG8_LAS bf16x8*)(lds + PG8_SB(b, h) + boff + n * 2048 + k * 1024); } while (0)
#define PG8_MMA(ai, bj, At, Bt) do { __builtin_amdgcn_s_setprio(1); _Pragma("unroll") for (int m = 0; m < 4; ++m) _Pragma("unroll") for (int n = 0; n < 2; ++n) _Pragma("unroll") for (int k = 0; k < 2; ++k) \
        acc[ai][bj][m][n] = __builtin_amdgcn_mfma_f32_16x16x32_bf16(Bt[n][k], At[m][k], acc[ai][bj][m][n], 0, 0, 0); __builtin_amdgcn_s_setprio(0); } while (0)
#define PG8_WAIT_V(n) asm volatile("s_waitcnt vmcnt(" #n ")" ::: "memory")
#define PG8_WAIT_L(n) asm volatile("s_waitcnt lgkmcnt(" #n ")" ::: "memory")
#define PG8_BAR __builtin_amdgcn_s_barrier()
#define PG8_SCHED __builtin_amdgcn_sched_barrier(0)
    Unit cur, nxt; int ui = 0;
    if (!S.next(0, cur)) return;
    f32x4 acc[2][2][4][2];
#pragma unroll
    for (int a = 0; a < 2; ++a)
#pragma unroll
        for (int b = 0; b < 2; ++b)
#pragma unroll
            for (int m = 0; m < 4; ++m)
#pragma unroll
                for (int n = 0; n < 2; ++n) acc[a][b][m][n] = (f32x4){0.f, 0.f, 0.f, 0.f};
    bf16x8 At[4][2], B0[2][2], B1[2][2];
    const char* cA = (const char*)g.A + (size_t)cur.pm * tstepA; const char* cB = (const char*)g.Bt + (size_t)cur.pn * tstepB;
    S.a_ready(cur);
    if constexpr (SP2) {
        PG8_STAGE(PG8_SB(0, 0), cB, voffB); PG8_STAGE(PG8_SB(0, 1), cB + hstepB, voffB); PG8_STAGE(PG8_SA(0, 0), cA, voffA); PG8_STAGE(PG8_SA(0, 1), cA + hstepA, voffA);
        if (wr == 1) PG8_BAR;
        PG8_WAIT_V(2); PG8_BAR;
        PG8_STAGE(PG8_SB(1, 0), cB + kstep, voffB); PG8_STAGE(PG8_SA(1, 0), cA + kstep, voffA); PG8_STAGE(PG8_SB(1, 1), cB + hstepB + kstep, voffB);
        PG8_WAIT_V(6); PG8_BAR;
    } else {
        PG8_STAGE(PG8_SB(0, 0), cB, voffB); PG8_STAGE(PG8_SA(0, 0), cA, voffA); PG8_STAGE(PG8_SB(0, 1), cB + hstepB, voffB); PG8_STAGE(PG8_SA(0, 1), cA + hstepA, voffA);
        if (wr == 1) PG8_BAR;
        PG8_WAIT_V(4); PG8_BAR;
        PG8_STAGE(PG8_SB(1, 0), cB + kstep, voffB); PG8_STAGE(PG8_SA(1, 0), cA + kstep, voffA); PG8_STAGE(PG8_SB(1, 1), cB + hstepB + kstep, voffB);
        PG8_WAIT_V(6); PG8_BAR;
    }
    for (;;) {
        const bool has_next = S.next(ui + 1, nxt);
        const char* nA = has_next ? (const char*)g.A + (size_t)nxt.pm * tstepA : cA; const char* nB = has_next ? (const char*)g.Bt + (size_t)nxt.pn * tstepB : cB;
        for (int t = 0; t < nt; t += 2) {
            if constexpr (Epi::MIDHOOK) { if (t == (nt >> 1)) E.mid(acc, cur, wr, wc, fr, fq); }
            const bool last = (t == nt - 2);
            const char* a1 = cA + (size_t)(t + 1) * kstep;
            const char* a2 = last ? nA : cA + (size_t)(t + 2) * kstep; const char* b2 = last ? nB : cB + (size_t)(t + 2) * kstep;
            const char* a3 = a2 + kstep; const char* b3 = b2 + kstep;
            if (last && has_next) S.a_ready(nxt);
            if constexpr (SP2) {
            PG8_LDB(B0, 0, 0); PG8_LDB(B1, 0, 1); PG8_SCHED; PG8_LDA(At, 0, 0); PG8_STAGE(PG8_SA(1, 1), a1 + hstepA, voffA);
            PG8_WAIT_V(8); PG8_WAIT_L(0); PG8_BAR; PG8_MMA(0, 0, At, B0); PG8_MMA(0, 1, At, B1); PG8_BAR; PG8_SCHED;
            PG8_LDA(At, 0, 1); PG8_STAGE(PG8_SB(0, 0), b2, voffB); PG8_STAGE(PG8_SB(0, 1), b2 + hstepB, voffB); PG8_STAGE(PG8_SA(0, 0), a2, voffA);
            PG8_WAIT_V(8); PG8_WAIT_L(0); PG8_BAR; PG8_MMA(1, 0, At, B0); PG8_MMA(1, 1, At, B1); PG8_BAR; PG8_SCHED;
            PG8_LDB(B0, 1, 0); PG8_LDB(B1, 1, 1); PG8_SCHED; PG8_LDA(At, 1, 0); PG8_STAGE(PG8_SA(0, 1), a2 + hstepA, voffA);
            PG8_WAIT_V(8); PG8_WAIT_L(0); PG8_BAR; PG8_MMA(0, 0, At, B0); PG8_MMA(0, 1, At, B1); PG8_BAR; PG8_SCHED;
            PG8_LDA(At, 1, 1); PG8_STAGE(PG8_SB(1, 0), b3, voffB); PG8_STAGE(PG8_SB(1, 1), b3 + hstepB, voffB); PG8_STAGE(PG8_SA(1, 0), a3, voffA);
            PG8_WAIT_V(8); PG8_WAIT_L(0); PG8_BAR; PG8_MMA(1, 0, At, B0); PG8_MMA(1, 1, At, B1); PG8_BAR; PG8_SCHED;
            } else {
            PG8_LDB(B0, 0, 0); PG8_SCHED; PG8_LDA(At, 0, 0); PG8_STAGE(PG8_SA(1, 1), a1 + hstepA, voffA);
            PG8_WAIT_L(8); PG8_BAR; PG8_WAIT_L(0); PG8_MMA(0, 0, At, B0); PG8_BAR; PG8_SCHED;
            PG8_LDB(B1, 0, 1); PG8_STAGE(PG8_SB(0, 0), b2, voffB);
            PG8_BAR; PG8_WAIT_L(0); PG8_MMA(0, 1, At, B1); PG8_BAR;
            PG8_LDA(At, 0, 1); PG8_STAGE(PG8_SA(0, 0), a2, voffA);
            PG8_BAR; PG8_WAIT_L(0); PG8_MMA(1, 0, At, B0); PG8_BAR; PG8_SCHED;
            PG8_STAGE(PG8_SB(0, 1), b2 + hstepB, voffB);
            PG8_WAIT_V(6); PG8_BAR; PG8_MMA(1, 1, At, B1); PG8_BAR;
            PG8_LDB(B0, 1, 0); PG8_SCHED; PG8_LDA(At, 1, 0); PG8_STAGE(PG8_SA(0, 1), a2 + hstepA, voffA);
            PG8_WAIT_L(8); PG8_BAR; PG8_WAIT_L(0); PG8_MMA(0, 0, At, B0); PG8_BAR; PG8_SCHED;
            PG8_LDB(B1, 1, 1); PG8_STAGE(PG8_SB(1, 0), b3, voffB);
            PG8_BAR; PG8_WAIT_L(0); PG8_MMA(0, 1, At, B1); PG8_BAR;
            PG8_LDA(At, 1, 1); PG8_STAGE(PG8_SA(1, 0), a3, voffA);
            PG8_BAR; PG8_WAIT_L(0); PG8_MMA(1, 0, At, B0); PG8_BAR; PG8_SCHED;
            PG8_STAGE(PG8_SB(1, 1), b3 + hstepB, voffB);
            PG8_WAIT_V(6); PG8_BAR; PG8_MMA(1, 1, At, B1); PG8_BAR;
            }
        }
        if constexpr (ALIGN_EPI) { if (wr == 0) PG8_BAR; }
        if constexpr (!Epi::AFTER_DRAIN) { E(acc, cur, wr, wc, fr, fq); S.done(cur); }
        if (!has_next) break;
#pragma unroll
        for (int a = 0; a < 2; ++a)
#pragma unroll
            for (int b = 0; b < 2; ++b)
#pragma unroll
                for (int m = 0; m < 4; ++m)
#pragma unroll
                    for (int n = 0; n < 2; ++n) acc[a][b][m][n] = (f32x4){0.f, 0.f, 0.f, 0.f};
        cur = nxt; cA = nA; cB = nB; ++ui;
        if constexpr (ALIGN_EPI) { if (wr == 1) PG8_BAR; }
    }
    PG8_WAIT_V(0);
    if constexpr (!ALIGN_EPI) { if (wr == 0) PG8_BAR; }
    PG8_BAR;
    if constexpr (Epi::AFTER_DRAIN) { E.fused(acc, cur, wr, wc, fr, fq, lds, wid, lane); S.done(cur); }
#undef PG8_SA
#undef PG8_SB
#undef PG8_STAGE
#undef PG8_LDA
#undef PG8_LDB
#undef PG8_MMA
#undef PG8_WAIT_V
#undef PG8_WAIT_L
#undef PG8_BAR
#undef PG8_SCHED
}
}

namespace fox {
constexpr int D = 128; constexpr float THR = 24.f; constexpr bool WSKIP = false; constexpr int OSTR = 1024, ZSTR = 3072;
constexpr float SCALE = 0.08838834764831845f;
constexpr int NW = 8, QBLK = 32, KVBLK = 64, QB = NW * QBLK;
constexpr int SHM_V = KVBLK * D * 2, SHM_K = KVBLK * D * 2;
constexpr int BIAS_OFF = 2 * SHM_V + 2 * SHM_K + NW * 64 * 4, SLOT_OFF = BIAS_OFF + 512, LDS_BYTES = SLOT_OFF + 64;

using bf16 = __hip_bfloat16;
typedef short bf16x8 __attribute__((ext_vector_type(8)));
typedef short s16x4 __attribute__((ext_vector_type(4)));
typedef float f32x16 __attribute__((ext_vector_type(16)));
typedef float f32x4 __attribute__((ext_vector_type(4)));
typedef unsigned u32x4 __attribute__((ext_vector_type(4)));
template <class A, class Bt> struct same_t { static constexpr bool v = false; };
template <class A> struct same_t<A, A> { static constexpr bool v = true; };

#define KSWZ(row, colB) ((row) * 256 + ((colB) ^ (((row) & 7) << 4)))
#define SBAR() __builtin_amdgcn_sched_barrier(0)
__device__ __forceinline__ int v_st(int k, int c) { const int kk = (k & ~0xC) | ((k & 4) << 1) | ((k & 8) >> 1); return ((kk >> 3) * 4 + (c >> 5)) * 512 + ((kk & 7) * 32 + (c & 31)) * 2; }
__device__ __forceinline__ int v_rd_base(int lane) { return ((lane & 3) << 3) | (((lane >> 2) & 3) << 6) | (((lane >> 4) & 1) << 5) | (((lane >> 5) & 1) << 8); }
constexpr int v_rd_off(int d0, int ks, int half) { return d0 * 512 + ks * 4096 + half * 2048; }
__device__ __forceinline__ int crow(int r, int hi) { return (r & 3) + 8 * (r >> 2) + 4 * hi; }
__device__ __forceinline__ unsigned cvtpk(float lo, float hi) {
    unsigned r; asm volatile("v_cvt_pk_bf16_f32 %0, %1, %2" : "=v"(r) : "v"(lo), "v"(hi)); return r;
}
__device__ __forceinline__ bf16x8 pack8(f32x4 a, f32x4 b) {
    u32x4 w = {cvtpk(a[0], a[1]), cvtpk(a[2], a[3]), cvtpk(b[0], b[1]), cvtpk(b[2], b[3])};
    return *reinterpret_cast<bf16x8*>(&w);
}
template <class T> __device__ __forceinline__ bf16x8 load8(const T* p) {
    if constexpr (same_t<T, float>::v) { return pack8(*(const f32x4*)p, *(const f32x4*)(p + 4)); }
    else { return *reinterpret_cast<const bf16x8*>(p); }
}
__device__ __forceinline__ void mask_tile(f32x16& p0, f32x16& p1, int dq, unsigned W) {
    const float NEG = -__builtin_inff();
#pragma unroll
    for (int r = 0; r < 16; ++r) {
        const int c = (r & 3) + 8 * (r >> 2);
        if ((unsigned)(dq - c) >= W) p0[r] = NEG;
        if ((unsigned)(dq - c - 32) >= W) p1[r] = NEG;
    }
}
__device__ __forceinline__ void partialSM(f32x16& p0, f32x16& p1, float& m_reg, float& mn, float& alpha) {
    float pmax = p0[0]; for (int r = 1; r < 16; ++r) pmax = fmaxf(pmax, p0[r]); for (int r = 0; r < 16; ++r) pmax = fmaxf(pmax, p1[r]);
    { auto rr = __builtin_amdgcn_permlane32_swap(__float_as_uint(pmax), __float_as_uint(pmax), false, false);
      pmax = fmaxf(__uint_as_float(rr[0]), __uint_as_float(rr[1])); }
    constexpr float C2 = 1.4426950408889634f * SCALE;
    if (__builtin_expect(__all((pmax - m_reg) * SCALE <= THR), 1)) { mn = m_reg; alpha = 1.f; }
    else { mn = fmaxf(m_reg, pmax); alpha = __builtin_amdgcn_exp2f((m_reg - mn) * C2); m_reg = mn; }
    const float mnL = -mn * C2;
    for (int r = 0; r < 16; ++r) p0[r] = fmaf(p0[r], C2, mnL); for (int r = 0; r < 16; ++r) p1[r] = fmaf(p1[r], C2, mnL);
    for (int r = 0; r < 16; ++r) p0[r] = __builtin_amdgcn_exp2f(p0[r]);
}
__device__ __forceinline__ void finishSM(f32x16& p0, f32x16& p1, float alpha, float& l_reg, bf16x8& pa0, bf16x8& pa1, bf16x8& pa2, bf16x8& pa3) {
    for (int r = 0; r < 16; ++r) p1[r] = __builtin_amdgcn_exp2f(p1[r]);
    float ps = 0; for (int r = 0; r < 16; ++r) ps += p0[r]; for (int r = 0; r < 16; ++r) ps += p1[r];
    { auto rr = __builtin_amdgcn_permlane32_swap(__float_as_uint(ps), __float_as_uint(ps), false, false);
      ps = __uint_as_float(rr[0]) + __uint_as_float(rr[1]); }
    l_reg = l_reg * alpha + ps;
#define PK4(P, B_, OUT) do { unsigned a0 = cvtpk(P[B_+0], P[B_+1]), a1 = cvtpk(P[B_+2], P[B_+3]);                          \
        unsigned b0 = cvtpk(P[B_+4], P[B_+5]), b1 = cvtpk(P[B_+6], P[B_+7]);                                             \
        auto r0 = __builtin_amdgcn_permlane32_swap(a0, b0, false, false); auto r1 = __builtin_amdgcn_permlane32_swap(a1, b1, false, false); \
        u32x4 w = {r0[0], r1[0], r0[1], r1[1]}; OUT = *reinterpret_cast<bf16x8*>(&w); } while (0)
    PK4(p0, 0, pa0); PK4(p0, 8, pa1); PK4(p1, 0, pa2); PK4(p1, 8, pa3);
#undef PK4
}
template <int KB, bool SK>
__device__ __forceinline__ void qkt(f32x16& p0, f32x16& p1, const char* K_lds, int r32, int hi, const bf16x8* qr, bool act) {
    if (SK && !act) { const float NEG = -__builtin_inff();
#pragma unroll
        for (int r = 0; r < 16; ++r) { p0[r] = NEG; p1[r] = NEG; } return; }
    { const char* bb = K_lds + 2 * SHM_K + NW * 64 * 4 + KB * 256 + hi * 16;
      const f32x4 b0 = *(const f32x4*)(bb), b1 = *(const f32x4*)(bb + 32), b2 = *(const f32x4*)(bb + 64), b3 = *(const f32x4*)(bb + 96);
      const f32x4 c0 = *(const f32x4*)(bb + 128), c1 = *(const f32x4*)(bb + 160), c2 = *(const f32x4*)(bb + 192), c3 = *(const f32x4*)(bb + 224);
      p0 = (f32x16){b0[0], b0[1], b0[2], b0[3], b1[0], b1[1], b1[2], b1[3], b2[0], b2[1], b2[2], b2[3], b3[0], b3[1], b3[2], b3[3]};
      p1 = (f32x16){c0[0], c0[1], c0[2], c0[3], c1[0], c1[1], c1[2], c1[3], c2[0], c2[1], c2[2], c2[3], c3[0], c3[1], c3[2], c3[3]}; }
    const char* kb[4];
#pragma unroll
    for (int dd = 0; dd < 4; ++dd) kb[dd] = K_lds + KB * SHM_K + KSWZ(r32, (dd * 16 + hi * 8) * 2);
#pragma unroll
    for (int d0 = 0; d0 < 8; ++d0) { const char* a = kb[d0 & 3] + (d0 >> 2) * 128;
        bf16x8 b0 = *reinterpret_cast<const bf16x8*>(a);
        bf16x8 b1 = *reinterpret_cast<const bf16x8*>(a + 32 * 256);
        p0 = __builtin_amdgcn_mfma_f32_32x32x16_bf16(b0, qr[d0], p0, 0, 0, 0);
        p1 = __builtin_amdgcn_mfma_f32_32x32x16_bf16(b1, qr[d0], p1, 0, 0, 0); }
}
template <int VB, bool SK>
__device__ __forceinline__ void pv_tile(f32x16* o, int vb0, bf16x8 pa0, bf16x8 pa1, bf16x8 pa2, bf16x8 pa3, bool act) {
    if (SK && !act) return;
#define TRRD(dst, off) asm volatile("ds_read_b64_tr_b16 %0, %1 offset:%2" : "=&v"(dst) : "v"(vb0), "i"(off) : "memory")
#define PV_D0(d0) do { s16x4 l0, l1, l2, l3, h0, h1, h2, h3; constexpr int b_ = VB * SHM_V + v_rd_off(d0, 0, 0);     \
        TRRD(l0, b_); TRRD(h0, b_ + 2048); TRRD(l1, b_ + 4096); TRRD(h1, b_ + 6144); TRRD(l2, b_ + 8192); TRRD(h2, b_ + 10240); TRRD(l3, b_ + 12288); TRRD(h3, b_ + 14336); \
        asm volatile("s_waitcnt lgkmcnt(0)" ::: "memory"); SBAR();                 \
        o[d0] = __builtin_amdgcn_mfma_f32_32x32x16_bf16(pa0, (bf16x8){l0[0], l0[1], l0[2], l0[3], h0[0], h0[1], h0[2], h0[3]}, o[d0], 0, 0, 0);   \
        o[d0] = __builtin_amdgcn_mfma_f32_32x32x16_bf16(pa1, (bf16x8){l1[0], l1[1], l1[2], l1[3], h1[0], h1[1], h1[2], h1[3]}, o[d0], 0, 0, 0);   \
        o[d0] = __builtin_amdgcn_mfma_f32_32x32x16_bf16(pa2, (bf16x8){l2[0], l2[1], l2[2], l2[3], h2[0], h2[1], h2[2], h2[3]}, o[d0], 0, 0, 0);   \
        o[d0] = __builtin_amdgcn_mfma_f32_32x32x16_bf16(pa3, (bf16x8){l3[0], l3[1], l3[2], l3[3], h3[0], h3[1], h3[2], h3[3]}, o[d0], 0, 0, 0); } while (0)
    PV_D0(0); PV_D0(1); PV_D0(2); PV_D0(3);
#undef PV_D0
#undef TRRD
}

template <class TIn, class TOut> struct BlockRef { const TIn* Q; const TIn* K; const TIn* V; TOut* O; const float* KB; const unsigned short* Z; int P0; int JLO; };
template <class TIn> struct Seam {
    bf16x8 qr[8];
    bf16x8 st_v0, st_v1, st_k0, st_k1; float st_b; f32x4 sf0, sf1, sf2, sf3;
    f32x4 tq[16];
};
__device__ __forceinline__ int swa_jlo(int P0, int W) { const int lowk = P0 - W + 1; return lowk > 0 ? lowk / KVBLK : 0; }
#define ROW(p, k0, rr) ((p) + (size_t)((k0) + (rr)) * D + sc)
#define VMW() asm volatile("s_waitcnt vmcnt(0)" ::: "memory")
#define VMWN(n) asm volatile("s_waitcnt vmcnt(%0)" :: "i"(n) : "memory")
#define SLOAD_H(Kp, Vp, Bp, k0) do { S.st_v0 = load8<TIn>(ROW(Vp, k0, sr)); S.st_v1 = load8<TIn>(ROW(Vp, k0, 32 + sr)); S.st_b = (Bp)[(k0) + (r32 | (hi << 5))]; \
                         S.st_k0 = load8<TIn>(ROW(Kp, k0, sr)); S.st_k1 = load8<TIn>(ROW(Kp, k0, 32 + sr)); } while (0)
#define SWRITE_HK(bf) do { *(bf16x8*)(K_lds + (bf) * SHM_K + kws) = S.st_k0; *(bf16x8*)(K_lds + (bf) * SHM_K + kws + 32 * 256) = S.st_k1; if (wid == 0) *(float*)(K_lds + 2 * SHM_K + NW * 64 * 4 + (bf) * 256 + (r32 | (hi << 5)) * 4) = S.st_b; } while (0)
#define SWRITE_HV(bf) do { *(bf16x8*)(V_lds + (bf) * SHM_V + vst0) = S.st_v0; *(bf16x8*)(V_lds + (bf) * SHM_V + vst1) = S.st_v1; } while (0)
#define SWRITE_H(bf) do { SWRITE_HV(bf); SWRITE_HK(bf); } while (0)
#define SLOAD_F(p, k0) do { S.sf0 = *(const f32x4*)ROW(p, k0, sr); S.sf1 = *(const f32x4*)(ROW(p, k0, sr) + 4);                \
                            S.sf2 = *(const f32x4*)ROW(p, k0, 32 + sr); S.sf3 = *(const f32x4*)(ROW(p, k0, 32 + sr) + 4); } while (0)
#define SWRITE_KF(bf) do { *(bf16x8*)(K_lds + (bf) * SHM_K + kws) = pack8(S.sf0, S.sf1); *(bf16x8*)(K_lds + (bf) * SHM_K + kws + 32 * 256) = pack8(S.sf2, S.sf3); } while (0)
#define SWRITE_VF(bf) do { *(bf16x8*)(V_lds + (bf) * SHM_V + vst0) = pack8(S.sf0, S.sf1); *(bf16x8*)(V_lds + (bf) * SHM_V + vst1) = pack8(S.sf2, S.sf3); } while (0)
template <class TIn, class TOut>
__device__ __forceinline__ void causal_swa_prime(const BlockRef<TIn, TOut>& cur, int W, char* lds, Seam<TIn>& S) {
    constexpr bool F32 = same_t<TIn, float>::v;
    const int tid = threadIdx.x, wid = __builtin_amdgcn_readfirstlane(tid >> 6), lane = tid & 63, r32 = lane & 31, hi = lane >> 5;
    const int sr = tid >> 4, sc = (tid & 15) * 8, kws = KSWZ(sr, sc * 2); char* K_lds = lds + 2 * SHM_V;
    const int kb0 = cur.JLO * KVBLK;
    for (int d0 = 0; d0 < 8; ++d0) S.qr[d0] = load8<TIn>(cur.Q + (size_t)(wid * QBLK + r32) * D + d0 * 16 + hi * 8);
    if constexpr (F32) { SLOAD_F((const float*)cur.K, kb0); VMW(); SWRITE_KF(0); SBAR(); SLOAD_F((const float*)cur.V, kb0); }
    else { SLOAD_H(cur.K, cur.V, cur.KB, kb0); VMW(); SWRITE_HK(0); }
    __syncthreads();
}
template <class TIn, class TOut>
__device__ __forceinline__ void causal_swa_block(const BlockRef<TIn, TOut>& cur, const BlockRef<TIn, TOut>& nxt, int skv, int W, char* lds, Seam<TIn>& S) {
    constexpr bool F32 = same_t<TIn, float>::v;
    const int tid = threadIdx.x, wid = __builtin_amdgcn_readfirstlane(tid >> 6), lane = tid & 63, r32 = lane & 31, hi = lane >> 5;
    const int j_lo = cur.JLO;
    int j_hi = (cur.P0 + QB - 1) / KVBLK + 1; if (j_hi > skv / KVBLK) j_hi = skv / KVBLK;
    const int NT = j_hi - j_lo;
    const int kbn = nxt.JLO * KVBLK;
    const int qlo = cur.P0 + wid * QBLK, qm = qlo + r32 - 4 * hi;
    char* V_lds = lds; char* K_lds = lds + 2 * SHM_V;
    float* ws = (float*)(lds + 2 * SHM_V + 2 * SHM_K) + wid * 64; float* li_l = ws, * al_l = ws + 32;
    float m_reg = -1e30f, l_reg = 0; f32x16 o[4] = {};
    const int sr = tid >> 4, sc = (tid & 15) * 8, vst0 = v_st(sr, sc), vst1 = v_st(32 + sr, sc), kws = KSWZ(sr, sc * 2);
    const int vb0 = (int)(uintptr_t)V_lds + v_rd_base(lane);
    const TIn* Kh = cur.K; const TIn* Vh = cur.V; const float* Bh = cur.KB;
#define RESC(a) do { if (__any((a) < 1.f)) { if (hi == 0) al_l[r32] = (a); asm volatile("s_waitcnt lgkmcnt(0)" ::: "memory");              \
                     for (int d_ = 0; d_ < 4; ++d_) for (int r = 0; r < 16; ++r) o[d_][r] *= al_l[crow(r, hi)]; } } while (0)
#define KBASE(t) ((j_lo + (t)) * KVBLK)
#define ACT(t) (KBASE(t) <= qlo + QBLK - 1 && KBASE(t) + KVBLK - 1 >= qlo - W + 1)
#define MASKT(P0_, P1_, t) do { const int kb_ = KBASE(t); if ((!SK || ACT(t)) && (kb_ + KVBLK - 1 > qlo || kb_ <= qlo + QBLK - 1 - W)) mask_tile(P0_, P1_, qm - kb_, (unsigned)W); } while (0)
    constexpr int NQL = F32 ? 16 : 8;
    constexpr bool SK = WSKIP && !F32;
#define SEAM_K0() do { VMWN(NQL); if constexpr (F32) { SWRITE_KF(0); SBAR(); SLOAD_F((const float*)nxt.V, kbn); } else { SWRITE_HK(0); } SBAR(); } while (0)
    f32x16 pA0, pA1, pB0, pB1; float mnA, mnB, alA, alB; bf16x8 pa0, pa1, pa2, pa3;
    if constexpr (F32) { VMW(); SWRITE_VF(0); SBAR(); } else { SWRITE_HV(0); SBAR(); }
    if (NT > 1) { if constexpr (F32) SLOAD_F((const float*)Kh, KBASE(1)); else SLOAD_H(Kh, Vh, Bh, KBASE(1)); }
    SBAR(); qkt<0, SK>(pA0, pA1, K_lds, r32, hi, S.qr, ACT(0));
    if constexpr (F32) { if (NT > 1) { VMW(); SWRITE_KF(1); SBAR(); SLOAD_F((const float*)Vh, KBASE(1)); } }
    MASKT(pA0, pA1, 0); partialSM(pA0, pA1, m_reg, mnA, alA);
    if (NT > 1) { VMW(); if constexpr (F32) { SWRITE_VF(1); SBAR(); if (NT > 2) SLOAD_F((const float*)Kh, KBASE(2)); } else SWRITE_H(1); }
    __syncthreads();
#define HALF_STEP(PX0, PX1, mnX, alX, PY0, PY1, alY, t, KB, VB, SB) do {                                                      \
        SBAR(); qkt<KB, SK>(PX0, PX1, K_lds, r32, hi, S.qr, ACT(t));                                             \
        finishSM(PY0, PY1, alY, l_reg, pa0, pa1, pa2, pa3); SBAR();                                                           \
        if ((t) + 1 < NT) { if constexpr (F32) { VMW(); SWRITE_KF(SB); SBAR(); SLOAD_F((const float*)Vh, KBASE((t) + 1)); }  \
                            else { SLOAD_H(Kh, Vh, Bh, KBASE((t) + 1)); } SBAR(); }                                               \
        pv_tile<VB, SK>(o, vb0, pa0, pa1, pa2, pa3, ACT((t) - 1)); MASKT(PX0, PX1, (t)); partialSM(PX0, PX1, m_reg, mnX, alX);                                        \
        __syncthreads();                                                                                                      \
        if ((t) + 1 < NT) { VMW(); if constexpr (F32) { SWRITE_VF(SB); SBAR(); if ((t) + 2 < NT) SLOAD_F((const float*)Kh, KBASE((t) + 2)); } \
                            else { SWRITE_H(SB); } }                                                                          \
        RESC(alX); __syncthreads(); } while (0)
    for (int t = 1; t + 1 < NT; t += 2) {
        HALF_STEP(pB0, pB1, mnB, alB, pA0, pA1, alA, t, 1, 0, 0);
        HALF_STEP(pA0, pA1, mnA, alA, pB0, pB1, alB, t + 1, 0, 1, 1);
    }
    const bool even = (NT & 1) == 0;
    if (even) { SBAR(); qkt<1, SK>(pB0, pB1, K_lds, r32, hi, S.qr, ACT(NT - 1)); SBAR(); }
#define QROW(e) (nxt.Q + (size_t)(wid * QBLK + r32) * D + ((e) >> 1) * 16 + hi * 8 + ((e) & 1) * 4)
    if constexpr (F32) { SLOAD_F((const float*)nxt.K, kbn); SBAR();
#pragma unroll
        for (int e = 0; e < 8; ++e) S.tq[e] = *(const f32x4*)QROW(e); }
    else { SLOAD_H(nxt.K, nxt.V, nxt.KB, kbn); SBAR();
#pragma unroll
        for (int d0 = 0; d0 < 8; ++d0) S.qr[d0] = load8<TIn>(nxt.Q + (size_t)(wid * QBLK + r32) * D + d0 * 16 + hi * 8); }
    SBAR();
    finishSM(pA0, pA1, alA, l_reg, pa0, pa1, pa2, pa3); SBAR();
    if constexpr (F32) {
#pragma unroll
        for (int e = 8; e < 16; ++e) S.tq[e] = *(const f32x4*)QROW(e); SBAR(); }
#undef QROW
    pv_tile<0, SK>(o, vb0, pa0, pa1, pa2, pa3, ACT(even ? NT - 2 : NT - 1));
    if (even) { MASKT(pB0, pB1, NT - 1); partialSM(pB0, pB1, m_reg, mnB, alB); __syncthreads(); RESC(alB);
        finishSM(pB0, pB1, alB, l_reg, pa0, pa1, pa2, pa3); SBAR(); pv_tile<1, SK>(o, vb0, pa0, pa1, pa2, pa3, ACT(NT - 1)); }
    SBAR(); SEAM_K0();
    if (hi == 0) li_l[r32] = l_reg; asm volatile("s_waitcnt lgkmcnt(0)" ::: "memory");
    float rli[16];
#pragma unroll
    for (int r = 0; r < 16; ++r) rli[r] = __builtin_amdgcn_rcpf(li_l[crow(r, hi)]);
    TOut* Ow = cur.O + (size_t)((wid * QBLK + 4 * hi) * OSTR + r32); const unsigned short* Zw = cur.Z + (size_t)((wid * QBLK + 4 * hi) * ZSTR + r32);
#pragma unroll
    for (int r = 0; r < 16; ++r) { const int orow = (r & 3) + 8 * (r >> 2);
#pragma unroll
        for (int d0 = 0; d0 < 4; ++d0) { const float zg = __uint_as_float((unsigned)Zw[orow * ZSTR + d0 * 32] << 16);
            const float v = o[d0][r] * rli[r] * zg * __builtin_amdgcn_rcpf(1.f + __builtin_amdgcn_exp2f(-1.4426950408889634f * zg));
            if constexpr (same_t<TOut, float>::v) { Ow[orow * OSTR + d0 * 32] = v; }
            else { const float vn = __shfl_xor(v, 1);
                   if ((r32 & 1) == 0) *(unsigned*)(Ow + orow * OSTR + d0 * 32) = cvtpk(v, vn); } }
        if (r & 1) asm volatile("" ::: "memory"); }
    if constexpr (F32) {
#pragma unroll
        for (int d0 = 0; d0 < 8; ++d0) S.qr[d0] = pack8(S.tq[2 * d0], S.tq[2 * d0 + 1]); }
    __syncthreads();
#undef RESC
#undef KBASE
#undef ACT
#undef MASKT
#undef SEAM_K0
#undef HALF_STEP
}
#undef ROW
#undef VMW
#undef VMWN
#undef SLOAD_H
#undef SWRITE_HK
#undef SWRITE_HV
#undef SWRITE_H
#undef SLOAD_F
#undef SWRITE_KF
#undef SWRITE_VF

}
constexpr int LDS_TOTAL = 159744;
constexpr int GEMM_X_OFF = 131072;

__device__ __forceinline__ int phys2log(int n) {
    if (n < 1536) return n;
    if (n < 2048) return n + 8;
    if (n < 3584) return n + 8;
    if (n < 4096) return n + 12;
    return n + 12;
}

__device__ void phase_prologue(const Params& p, unsigned char* lds) {
    const int tid = threadIdx.x, lane = tid & 63, w = tid >> 6;
    float* L = (float*)lds;
    if (blockIdx.x == 0 && tid < 16) { ((unsigned*)(p.ws + WS_CTRL))[tid] = 0u; }
    if (blockIdx.x < 48) {
        const int j = blockIdx.x * 64 + lane;
        float acc[8] = {0.f, 0.f, 0.f, 0.f, 0.f, 0.f, 0.f, 0.f};
        for (int k = w * 128; k < w * 128 + 128; ++k) { const float wv = p.w_ada[(size_t)k * 3072 + j];
#pragma unroll
            for (int b = 0; b < 8; ++b) acc[b] += p.c[b * 1024 + k] * wv; }
#pragma unroll
        for (int b = 0; b < 8; ++b) L[(w * 8 + b) * 64 + lane] = acc[b];
        __syncthreads();
        { const int b = w; float s = p.b_ada[j];
#pragma unroll
          for (int ww = 0; ww < 8; ++ww) s += L[(ww * 8 + b) * 64 + lane];
          ((float*)(p.ws + WS_MOD))[b * 3072 + j] = s; }
        __syncthreads();
    }
    { const int gt = blockIdx.x * 512 + tid;
      if (gt < 12288) { const int j = gt >> 10, k = gt & 1023; const int col = j < 8 ? 1536 + j : 3592 + (j - 8);
          ((float*)(p.ws + WS_WSMALL))[gt] = p.w_in[(size_t)k * DIN + col]; } }
    unsigned short* WIN_T = (unsigned short*)(p.ws + WS_WIN_T); unsigned short* WO2_T = (unsigned short*)(p.ws + WS_WO2_T); unsigned short* WOUT2_T = (unsigned short*)(p.ws + WS_WOUT2_T);
    for (int tile = blockIdx.x; tile < 2048; tile += gridDim.x) {
        const float* src; int sld; unsigned short* dst; int dld; unsigned short* dst2 = nullptr;
        if (tile < 1536) { const int kt = tile / 96, nt = tile % 96; src = p.w_in + (size_t)(kt * 64) * DIN + phys2log(nt * 64); sld = DIN; dst = WIN_T + (size_t)(nt * 64) * 1024 + kt * 64; dld = 1024; }
        else if (tile < 1792) { const int idx = tile - 1536, nt = idx & 31, kt = idx >> 5; src = (nt < 16 ? p.w_o_gdn : p.w_o_fox) + (size_t)(kt * 64) * 1024 + (nt & 15) * 64; sld = 1024; dst = WO2_T + (size_t)((nt & 15) * 64) * 1024 + (nt < 16 ? 0 : 512) + kt * 64; dld = 1024; }
        else { const int idx = tile - 1792, nt = idx & 15, kt = idx >> 4; src = p.w_out + (size_t)(kt * 64) * 1024 + nt * 64; sld = 1024; dst = WOUT2_T + (size_t)(nt * 64) * 2048 + kt * 64; dld = 2048; dst2 = dst + 1024; }
        { const int i = tid >> 3, js = (tid & 7) * 8;
          const float4 a = *(const float4*)(src + (size_t)i * sld + js), b = *(const float4*)(src + (size_t)i * sld + js + 4);
          float* r = L + i * 65 + js; r[0] = a.x; r[1] = a.y; r[2] = a.z; r[3] = a.w; r[4] = b.x; r[5] = b.y; r[6] = b.z; r[7] = b.w; }
        __syncthreads();
        { const int n = tid >> 3, ks = (tid & 7) * 8; float v[8];
#pragma unroll
          for (int q = 0; q < 8; ++q) v[q] = L[(ks + q) * 65 + n];
          uint4 o; o.x = pk_bf16(v[0], v[1]); o.y = pk_bf16(v[2], v[3]); o.z = pk_bf16(v[4], v[5]); o.w = pk_bf16(v[6], v[7]);
          *(uint4*)(dst + (size_t)n * dld + ks) = o; if (dst2) *(uint4*)(dst2 + (size_t)n * dld + ks) = o; }
        __syncthreads();
    }
}

__device__ void phase_prepass(const Params& p, unsigned char* lds) {
    const int tid = threadIdx.x, lane = tid & 63, w = tid >> 6, l5 = lane & 31, up = lane >> 5;
    float* Wsm = (float*)lds;
    { const float* src = (const float*)(p.ws + WS_WSMALL); for (int i = tid; i < 12288; i += 512) Wsm[i] = src[i]; }
    __syncthreads();
    const float* mod = (const float*)(p.ws + WS_MOD);
    unsigned short* HB = (unsigned short*)(p.ws + WS_HB);
    float* GDEC = (float*)(p.ws + WS_GDEC); float* BETA = (float*)(p.ws + WS_BETA); float* LOGF = (float*)(p.ws + WS_LOGF);
    const int nwave = gridDim.x * 8, rows_per = MTOK / nwave;
    const int gw = blockIdx.x * 8 + w;
    const float gA = l5 < 4 ? -__expf(p.A_log[l5 & 3]) : 0.f;
    const float gbias = l5 < 4 ? p.dt_bias[l5 & 3] : (l5 >= 8 && l5 < 12 ? p.b_f[l5 & 3] : 0.f);
    float* gdst = (l5 < 4 ? GDEC : (l5 < 8 ? BETA : LOGF)) + (l5 & 3);
    for (int r0 = gw * rows_per; r0 < (gw + 1) * rows_per; r0 += 32) {
        const int b = r0 >> 13;
        float4 gs[4], sh[4];
#pragma unroll
        for (int i = 0; i < 4; ++i) { const int e = i * 256 + lane * 4; const float4 g = *(const float4*)(p.g_norm + e), sc = *(const float4*)(mod + b * 3072 + 1024 + e); sh[i] = *(const float4*)(mod + b * 3072 + e);
            gs[i].x = g.x * (1.f + sc.x); gs[i].y = g.y * (1.f + sc.y); gs[i].z = g.z * (1.f + sc.z); gs[i].w = g.w * (1.f + sc.w); }
        const int rend = (r0 + 32 < (gw + 1) * rows_per) ? r0 + 32 : (gw + 1) * rows_per;
        float4 xn0[4], xn1[4];
        { const int rb = (r0 + 1 < rend) ? r0 + 1 : r0;
#pragma unroll
          for (int i = 0; i < 4; ++i) { xn0[i] = *(const float4*)(p.x + (size_t)r0 * DM + i * 256 + lane * 4); xn1[i] = *(const float4*)(p.x + (size_t)rb * DM + i * 256 + lane * 4); } }
#pragma unroll 1
        for (int r = r0; r < rend; r += 2) {
            const bool hasb = r + 1 < rend;
            float4 xa[4], xb[4]; float ssa = 0.f, ssb = 0.f;
#pragma unroll
            for (int i = 0; i < 4; ++i) { xa[i] = xn0[i]; xb[i] = xn1[i];
                ssa += xa[i].x * xa[i].x + xa[i].y * xa[i].y + xa[i].z * xa[i].z + xa[i].w * xa[i].w; ssb += xb[i].x * xb[i].x + xb[i].y * xb[i].y + xb[i].z * xb[i].z + xb[i].w * xb[i].w; }
            { const int ra = (r + 2 < rend) ? r + 2 : r, rb = (r + 3 < rend) ? r + 3 : ra;
#pragma unroll
              for (int i = 0; i < 4; ++i) { xn0[i] = *(const float4*)(p.x + (size_t)ra * DM + i * 256 + lane * 4); xn1[i] = *(const float4*)(p.x + (size_t)rb * DM + i * 256 + lane * 4); } }
            float rstd_a, rstd_b;
            { float v = up ? ssb : ssa; const float snd = up ? ssa : ssb; v += __shfl_xor(snd, 32);
#pragma unroll
              for (int o = 16; o >= 1; o >>= 1) v += __shfl_xor(v, o);
              const float ta = __shfl(v, 0), tb = __shfl(v, 32);
              rstd_a = __builtin_amdgcn_rsqf(ta * (1.0f / 1024.0f) + 1e-6f); rstd_b = __builtin_amdgcn_rsqf(tb * (1.0f / 1024.0f) + 1e-6f); }
#pragma unroll
            for (int i = 0; i < 4; ++i) {
                xa[i].x = xa[i].x * rstd_a * gs[i].x + sh[i].x; xa[i].y = xa[i].y * rstd_a * gs[i].y + sh[i].y; xa[i].z = xa[i].z * rstd_a * gs[i].z + sh[i].z; xa[i].w = xa[i].w * rstd_a * gs[i].w + sh[i].w;
                xb[i].x = xb[i].x * rstd_b * gs[i].x + sh[i].x; xb[i].y = xb[i].y * rstd_b * gs[i].y + sh[i].y; xb[i].z = xb[i].z * rstd_b * gs[i].z + sh[i].z; xb[i].w = xb[i].w * rstd_b * gs[i].w + sh[i].w;
                uint2 o; o.x = pk_bf16(xa[i].x, xa[i].y); o.y = pk_bf16(xa[i].z, xa[i].w); *(uint2*)(HB + (size_t)r * DM + i * 256 + lane * 4) = o;
                if (hasb) { uint2 o2; o2.x = pk_bf16(xb[i].x, xb[i].y); o2.y = pk_bf16(xb[i].z, xb[i].w); *(uint2*)(HB + (size_t)(r + 1) * DM + i * 256 + lane * 4) = o2; } }
            float mine = 0.f;
#pragma unroll
            for (int j = 0; j < 12; ++j) { float da = 0.f, db = 0.f;
#pragma unroll
                for (int i = 0; i < 4; ++i) { const float4 wv = *(const float4*)(Wsm + j * 1024 + i * 256 + lane * 4);
                    da += xa[i].x * wv.x + xa[i].y * wv.y + xa[i].z * wv.z + xa[i].w * wv.w; db += xb[i].x * wv.x + xb[i].y * wv.y + xb[i].z * wv.z + xb[i].w * wv.w; }
                float v = up ? db : da; const float snd = up ? da : db; v += __shfl_xor(snd, 32);
#pragma unroll
                for (int o = 16; o >= 1; o >>= 1) v += __shfl_xor(v, o);
                if (l5 == j) mine = v; }
            if (l5 < 12 && (up == 0 || hasb)) {
                const float t = mine + gbias, u = l5 < 4 ? t : -t;
                const float sp = fmaxf(u, 0.f) + __logf(1.f + __expf(-fabsf(u)));
                gdst[(size_t)(r + up) * 4] = l5 < 4 ? gA * sp : (l5 < 8 ? __expf(-sp) : -sp); }
        }
    }
    __syncthreads();
}

__device__ void phase_cumsum(const Params& p, unsigned char* lds) {
    if (blockIdx.x >= 32) return;
    const int tid = threadIdx.x, lane = tid & 63, w = tid >> 6, bh = blockIdx.x, b = bh >> 2, h = bh & 3;
    float* L = (float*)lds;
    const float* LOGF = (const float*)(p.ws + WS_LOGF); float* KB = (float*)(p.ws + WS_KBIAS) + (size_t)bh * SEQ;
    float v[16]; float s = 0.f;
#pragma unroll
    for (int i = 0; i < 16; ++i) { s += LOGF[((size_t)b * SEQ + tid * 16 + i) * 4 + h]; v[i] = s; }
    float incl = s;
#pragma unroll
    for (int o = 1; o < 64; o <<= 1) { const float t = __shfl_up(incl, o); if (lane >= o) incl += t; }
    if (lane == 63) L[w] = incl;
    __syncthreads();
    float pre = incl - s;
    for (int ww = 0; ww < w; ++ww) pre += L[ww];
#pragma unroll
    for (int i = 0; i < 16; ++i) KB[tid * 16 + i] = -(pre + v[i]) * 11.313708498984761f;
    float* kbEnd = L + 16; float* kbStart = L + 16 + 128; float* gm = L + 16 + 128 + 32;
    if ((tid & 3) == 3) kbEnd[tid >> 2] = -(pre + v[15]) * 11.313708498984761f;
    if ((tid & 15) == 0) kbStart[tid >> 4] = -(pre + v[0]) * 11.313708498984761f;
    if (tid < 128) { gm[tid] = fabsf(p.g_q_fox[tid]); gm[128 + tid] = fabsf(p.g_k_fox[tid]); }
    __syncthreads();
    if (tid < 32) { float gq = 0.f, gk = 0.f;
        for (int i = 0; i < 128; ++i) { gq = fmaxf(gq, gm[i]); gk = fmaxf(gk, gm[128 + i]); }
        const float M = 11.5f * gq * gk, thrK = 11.313708498984761f * (111.0f + 2.0f * M);
        const int qb = tid; const float ks = kbStart[qb]; int j = 0;
        while (j < 4 * qb && ks - kbEnd[j] > thrK) ++j;
        ((int*)(p.ws + WS_JLO))[bh * 32 + qb] = j; }
    __syncthreads();
}

typedef float f32x2 __attribute__((ext_vector_type(2)));
__device__ void gdn_stage_chunk(const Params& p, float* Q, float* K, float* V, float* GA, float* GB, int b, int h, int t0) {
    const int tid = threadIdx.x; const int s = tid >> 3, dg = tid & 7;
    const unsigned short* GQKV = (const unsigned short*)(p.ws + WS_GQKV);
#pragma unroll 1
    for (int part = 0; part < 3; ++part) {
        const int ch0 = part * 512 + h * 128 + dg * 16;
        float a[16];
#pragma unroll
        for (int c = 0; c < 16; ++c) a[c] = 0.f;
#pragma unroll
        for (int i = 0; i < 4; ++i) { const int tt = t0 + s - 3 + i;
            if (tt >= 0) { const uint4 u0 = *(const uint4*)(GQKV + ((size_t)b * SEQ + tt) * 1536 + ch0), u1 = *(const uint4*)(GQKV + ((size_t)b * SEQ + tt) * 1536 + ch0 + 8);
                const unsigned uu[8] = {u0.x, u0.y, u0.z, u0.w, u1.x, u1.y, u1.z, u1.w};
                const float* wp = p.conv_w + i * 1536 + ch0;
#pragma unroll
                for (int q = 0; q < 8; ++q) { a[2 * q] += wp[2 * q] * __uint_as_float(uu[q] << 16); a[2 * q + 1] += wp[2 * q + 1] * __uint_as_float(uu[q] & 0xffff0000u); } } }
        float ss = 0.f;
#pragma unroll
        for (int c = 0; c < 16; ++c) { a[c] = siluf_(a[c]); ss += a[c] * a[c]; }
        float* dst = V;
        if (part < 2) { ss += __shfl_xor(ss, 1); ss += __shfl_xor(ss, 2); ss += __shfl_xor(ss, 4);
            float r = 1.0f / sqrtf(ss + 1e-6f); if (part == 0) r *= 0.08838834764831845f;
#pragma unroll
            for (int c = 0; c < 16; ++c) a[c] *= r;
            dst = part == 0 ? Q : K; }
#pragma unroll
        for (int c = 0; c < 16; c += 4) *(float4*)(dst + s * 128 + dg * 16 + c) = make_float4(a[c], a[c + 1], a[c + 2], a[c + 3]);
    }
    if (tid < 64) { GA[tid] = __expf(((const float*)(p.ws + WS_GDEC))[((size_t)b * SEQ + t0 + tid) * 4 + h]); GB[tid] = ((const float*)(p.ws + WS_BETA))[((size_t)b * SEQ + t0 + tid) * 4 + h]; }
}
__device__ void gdn_epilogue_chunk(const Params& p, const float* O, int b, int h, int t0) {
    const int tid = threadIdx.x; const int s = tid >> 3, dg = tid & 7;
    float o[16]; float ss = 0.f;
#pragma unroll
    for (int c = 0; c < 16; c += 4) { const float4 v = *(const float4*)(O + s * 128 + dg * 16 + c); o[c] = v.x; o[c + 1] = v.y; o[c + 2] = v.z; o[c + 3] = v.w; }
#pragma unroll
    for (int c = 0; c < 16; ++c) ss += o[c] * o[c];
    ss += __shfl_xor(ss, 1); ss += __shfl_xor(ss, 2); ss += __shfl_xor(ss, 4);
    const float rstd = 1.0f / sqrtf(ss * (1.0f / 128.0f) + 1e-6f);
    const size_t tok = (size_t)b * SEQ + t0 + s;
    const unsigned short* zp = (const unsigned short*)(p.ws + WS_ZG) + tok * 3072 + h * 128 + dg * 16;
    const uint4 z0 = *(const uint4*)zp, z1 = *(const uint4*)(zp + 8);
    const unsigned zz[8] = {z0.x, z0.y, z0.z, z0.w, z1.x, z1.y, z1.z, z1.w};
    unsigned ow[8];
#pragma unroll
    for (int q = 0; q < 8; ++q) { const float za = __uint_as_float(zz[q] << 16), zb = __uint_as_float(zz[q] & 0xffff0000u);
        const float va = o[2 * q] * rstd * p.g_gdn_out[dg * 16 + 2 * q] * siluf_(za), vb = o[2 * q + 1] * rstd * p.g_gdn_out[dg * 16 + 2 * q + 1] * siluf_(zb);
        ow[q] = pk_bf16(va, vb); }
    unsigned short* dst = (unsigned short*)(p.ws + WS_HB) + tok * 1024 + h * 128 + dg * 16;
    *(uint4*)dst = make_uint4(ow[0], ow[1], ow[2], ow[3]); *(uint4*)(dst + 8) = make_uint4(ow[4], ow[5], ow[6], ow[7]);
}
__device__ __forceinline__ void gdn_epilogue_chunk_z(const Params& p, const float* O, int b, int h, int t0, uint4 z0, uint4 z1) {
    const int tid = threadIdx.x; const int s = tid >> 3, dg = tid & 7;
    float o[16]; float ss = 0.f;
#pragma unroll
    for (int c = 0; c < 16; c += 4) { const float4 v = *(const float4*)(O + s * 128 + dg * 16 + c); o[c] = v.x; o[c + 1] = v.y; o[c + 2] = v.z; o[c + 3] = v.w; }
#pragma unroll
    for (int c = 0; c < 16; ++c) ss += o[c] * o[c];
    ss += __shfl_xor(ss, 1); ss += __shfl_xor(ss, 2); ss += __shfl_xor(ss, 4);
    const float rstd = 1.0f / sqrtf(ss * (1.0f / 128.0f) + 1e-6f);
    const size_t tok = (size_t)b * SEQ + t0 + s;
    const unsigned zz[8] = {z0.x, z0.y, z0.z, z0.w, z1.x, z1.y, z1.z, z1.w};
    unsigned ow[8];
#pragma unroll
    for (int q = 0; q < 8; ++q) { const float za = __uint_as_float(zz[q] << 16), zb = __uint_as_float(zz[q] & 0xffff0000u);
        const float va = o[2 * q] * rstd * p.g_gdn_out[dg * 16 + 2 * q] * siluf_(za), vb = o[2 * q + 1] * rstd * p.g_gdn_out[dg * 16 + 2 * q + 1] * siluf_(zb);
        ow[q] = pk_bf16(va, vb); }
    unsigned short* dst = (unsigned short*)(p.ws + WS_HB) + tok * 1024 + h * 128 + dg * 16;
    *(uint4*)dst = make_uint4(ow[0], ow[1], ow[2], ow[3]); *(uint4*)(dst + 8) = make_uint4(ow[4], ow[5], ow[6], ow[7]);
}
__device__ void gdn_seq_unit(const Params& p, unsigned char* lds, int bh) {
    float* Q = (float*)lds; float* K = Q + 8192; float* V = K + 8192; float* O = V + 8192; float* GA = O + 8192; float* GB = GA + 64;
    const int tid = threadIdx.x, b = bh >> 2, h = bh & 3;
    f32x2 st[64];
#pragma unroll
    for (int i = 0; i < 64; ++i) st[i] = (f32x2){0.f, 0.f};
    for (int ch = 0; ch < SEQ / 64; ++ch) {
        const int t0 = ch * 64;
        __syncthreads();
        gdn_stage_chunk(p, Q, K, V, GA, GB, b, h, t0);
        __syncthreads();
        if (tid < 128) {
#pragma unroll 1
            for (int s = 0; s < 64; ++s) {
                const float a = GA[s], be = GB[s], v = V[s * 128 + tid];
                f32x2 ks0 = {0.f, 0.f}, ks1 = {0.f, 0.f};
#pragma unroll
                for (int i = 0; i < 64; i += 2) { const float4 kv = *(const float4*)(K + s * 128 + 2 * i); ks0 += (f32x2){kv.x, kv.y} * st[i]; ks1 += (f32x2){kv.z, kv.w} * st[i + 1]; if ((i & 14) == 14) asm volatile("" ::: "memory"); }
                const float kS = a * ((ks0.x + ks0.y) + (ks1.x + ks1.y));
                const float dl = be * (v - kS);
                f32x2 os0 = {0.f, 0.f}, os1 = {0.f, 0.f};
#pragma unroll
                for (int i = 0; i < 64; i += 2) { const float4 kv = *(const float4*)(K + s * 128 + 2 * i); const float4 qv = *(const float4*)(Q + s * 128 + 2 * i);
                    st[i] = st[i] * a + (f32x2){kv.x, kv.y} * dl; st[i + 1] = st[i + 1] * a + (f32x2){kv.z, kv.w} * dl;
                    os0 += (f32x2){qv.x, qv.y} * st[i]; os1 += (f32x2){qv.z, qv.w} * st[i + 1]; if ((i & 6) == 6) asm volatile("" ::: "memory"); }
                O[s * 128 + tid] = (os0.x + os0.y) + (os1.x + os1.y);
            }
        }
        __syncthreads();
        gdn_epilogue_chunk(p, O, b, h, t0);
    }
    __syncthreads();
}

#ifndef PREP_REP
#define PREP_REP 0
#endif
namespace gdn2 {
typedef short bf16x8 __attribute__((ext_vector_type(8)));
typedef float f32x16 __attribute__((ext_vector_type(16)));
constexpr int RK = 272, RT_ = 144;
constexpr int O_QN = 0, O_KN = 17408, O_KT = 34816, O_VT = 53248, O_L = 71680, O_RT = 88064, O_TMU = 92160, O_TMW = 101376, O_QKM = 110592, O_ST = 119808, O_G = 154624, O_END = 155648;
constexpr int O_W = O_KN, O_VNT = O_VT, O_VNTD = O_L, O_OBUF = 0;
__device__ __forceinline__ int crow(int r, int hi) { return (r & 3) + 8 * (r >> 2) + 4 * hi; }
#define CRC(i) (((i) & 3) + 8 * ((i) >> 2))
__device__ __forceinline__ unsigned short f2bf(float v) { return (unsigned short)(pk_bf16c(v, 0.f) & 0xffffu); }
template <int KS> __device__ __forceinline__ f32x16 mm32(f32x16 acc, const unsigned char* A, int lda, const unsigned char* B, int ldb, int lane) {
    const int r = lane & 31, hi = lane >> 5;
    const unsigned char* ap = A + r * lda + hi * 16; const unsigned char* bp = B + r * ldb + hi * 16;
#pragma unroll
    for (int ks = 0; ks < KS; ++ks) { const bf16x8 a = *(const bf16x8*)(ap + ks * 32); const bf16x8 b = *(const bf16x8*)(bp + ks * 32); acc = __builtin_amdgcn_mfma_f32_32x32x16_bf16(a, b, acc, 0, 0, 0); }
    return acc;
}
struct RawRegs { uint4 r[8]; };
constexpr int O_RAW = 92160, RAWROW = 784, O_CW = 144896;
__device__ __forceinline__ void stage_load(const Params& p, RawRegs& R, int b, int h, int t0) {
    const int tid = threadIdx.x; const unsigned short* GQKV = (const unsigned short*)(p.ws + WS_GQKV);
#pragma unroll
    for (int j = 0; j < 4; ++j) { const int id = tid + 512 * j; const int r = id / 24, rem = id - r * 24, part = rem >> 3, dg = rem & 7; const int tt = t0 - 3 + r;
        if (id < 1608 && tt >= 0) { const unsigned short* src = GQKV + ((size_t)b * SEQ + tt) * 1536 + part * 512 + h * 128 + dg * 16; R.r[2 * j] = *(const uint4*)src; R.r[2 * j + 1] = *(const uint4*)(src + 8); }
        else { R.r[2 * j] = make_uint4(0u, 0u, 0u, 0u); R.r[2 * j + 1] = make_uint4(0u, 0u, 0u, 0u); } }
}
__device__ __forceinline__ void stage_store_raw(unsigned char* lds, const RawRegs& R) {
    const int tid = threadIdx.x;
#pragma unroll
    for (int j = 0; j < 4; ++j) { const int id = tid + 512 * j; if (id < 1608) { const int r_ = id / 24, rem_ = id - r_ * 24; unsigned char* d_ = lds + O_RAW + r_ * RAWROW + rem_ * 32; *(uint4*)d_ = R.r[2 * j]; *(uint4*)(d_ + 16) = R.r[2 * j + 1]; } }
}
__device__ void stage_compute(const Params& p, unsigned char* lds, int b, int h, int t0) {
    const int tid = threadIdx.x; const int s = tid >> 3, dg = tid & 7;
#pragma unroll 1
    for (int part = 0; part < 3; ++part) {
        const int ch0 = part * 512 + h * 128 + dg * 16;
        float a[16];
#pragma unroll
        for (int c = 0; c < 16; ++c) a[c] = 0.f;
#pragma unroll
        for (int i = 0; i < 4; ++i) { const unsigned char* rp = lds + O_RAW + (s + i) * RAWROW + (part * 8 + dg) * 32;
            const uint4 u0 = *(const uint4*)rp, u1 = *(const uint4*)(rp + 16);
            const unsigned uu[8] = {u0.x, u0.y, u0.z, u0.w, u1.x, u1.y, u1.z, u1.w};
            const float* wp = (const float*)(lds + O_CW) + (part * 4 + i) * 128 + dg * 16;
            float wv[16];
#pragma unroll
            for (int q = 0; q < 4; ++q) { const float4 t4 = *(const float4*)(wp + 4 * q); wv[4 * q] = t4.x; wv[4 * q + 1] = t4.y; wv[4 * q + 2] = t4.z; wv[4 * q + 3] = t4.w; }
#pragma unroll
            for (int q = 0; q < 8; ++q) { a[2 * q] += wv[2 * q] * __uint_as_float(uu[q] << 16); a[2 * q + 1] += wv[2 * q + 1] * __uint_as_float(uu[q] & 0xffff0000u); } }
        float ss = 0.f;
#pragma unroll
        for (int c = 0; c < 16; ++c) { a[c] = a[c] * __builtin_amdgcn_rcpf(1.f + __builtin_amdgcn_exp2f(-1.4426950408889634f * a[c])); ss += a[c] * a[c]; }
        if (part < 2) { ss += __shfl_xor(ss, 1); ss += __shfl_xor(ss, 2); ss += __shfl_xor(ss, 4);
            float r = __builtin_amdgcn_rsqf(ss + 1e-6f); if (part == 0) r *= 0.08838834764831845f;
#pragma unroll
            for (int c = 0; c < 16; ++c) a[c] *= r; }
        if (part < 2) { unsigned char* dst = lds + (part == 0 ? O_QN : O_KN) + s * RK + dg * 32;
            *(uint4*)dst = make_uint4(pk_bf16c(a[0], a[1]), pk_bf16c(a[2], a[3]), pk_bf16c(a[4], a[5]), pk_bf16c(a[6], a[7]));
            *(uint4*)(dst + 16) = make_uint4(pk_bf16c(a[8], a[9]), pk_bf16c(a[10], a[11]), pk_bf16c(a[12], a[13]), pk_bf16c(a[14], a[15])); }
        if (part >= 1) { unsigned char* dt = lds + (part == 1 ? O_KT : O_VT) + (dg * 16) * RT_ + s * 2;
#pragma unroll
            for (int c = 0; c < 16; ++c) *(unsigned short*)(dt + c * RT_) = f2bf(a[c]); }
    }
    if (tid < 64) { float* G = (float*)(lds + O_G);
        float g = ((const float*)(p.ws + WS_GDEC))[((size_t)b * SEQ + t0 + tid) * 4 + h];
#pragma unroll
        for (int o = 1; o < 64; o <<= 1) { const float t = __shfl_up(g, o); if (tid >= o) g += t; }
        const float gl = __shfl(g, 63);
        G[tid] = g; G[64 + tid] = ((const float*)(p.ws + WS_BETA))[((size_t)b * SEQ + t0 + tid) * 4 + h]; G[128 + tid] = __expf(g); G[192 + tid] = __expf(gl - g); }
}
__device__ __forceinline__ unsigned char* prepA(const Params& p, int bh, int ch) { return (unsigned char*)p.out + (size_t)(bh * 128 + ch) * 65536; }
__device__ __forceinline__ unsigned char* prepB(const Params& p, int bh, int ch) { return p.ws + WS_PREPB + (size_t)(bh * 128 + ch) * 8704; }
__device__ void prep_unit(const Params& p, unsigned char* lds, int bh, int ch, RawRegs& R, bool has_next, int bh_n, int ch_n) {
    const int tid = threadIdx.x, lane = tid & 63, w = tid >> 6, hi = lane >> 5, l31 = lane & 31, b = bh >> 2, h = bh & 3;
    float* Lf = (float*)(lds + O_L); float* RTm = (float*)(lds + O_RT); const float* GC = (const float*)(lds + O_G); const float* BE = GC + 64; const float* EG = GC + 128;
    const int t0 = ch * 64;
    unsigned char* ga = prepA(p, bh, ch); unsigned char* gb = prepB(p, bh, ch);
    __syncthreads();
    stage_store_raw(lds, R);
    if (has_next) stage_load(p, R, bh_n >> 2, bh_n & 3, ch_n * 64);
    __syncthreads();
    stage_compute(p, lds, b, h, t0);
    __syncthreads();
    if (PREP_REP & 1) { stage_compute(p, lds, b, h, t0); __syncthreads(); }
#pragma unroll
    for (int i = 0; i < 2; ++i) { const int pc = tid + i * 512;
        *(uint4*)(ga + 32768 + pc * 16) = *(const uint4*)(lds + O_QN + (pc >> 4) * RK + (pc & 15) * 16);
        *(uint4*)(ga + 49152 + pc * 16) = *(const uint4*)(lds + O_KT + (pc >> 3) * RT_ + (pc & 7) * 16); }
    if (tid < 32) *(uint4*)(gb + 8192 + tid * 16) = *(const uint4*)(lds + O_G + 512 + tid * 16);
#pragma unroll 1
    for (int rep2 = 0; rep2 < ((PREP_REP & 16) ? 2 : 1); ++rep2) {
#pragma unroll 1
    for (int rep = 0; rep < ((PREP_REP & 2) ? 2 : 1); ++rep) {
    { const int tr = (w >> 1) & 1, tc = w & 1; const bool isQ = w >= 4;
      f32x16 acc;
#pragma unroll
      for (int i = 0; i < 16; ++i) acc[i] = 0.f;
      acc = mm32<8>(acc, lds + (isQ ? O_QN : O_KN) + tr * 32 * RK, RK, lds + O_KN + tc * 32 * RK, RK, lane);
      const int s = tc * 32 + l31; const float gs = GC[s]; const int cb = tr * 32 + 4 * hi;
      const float* gcb = GC + cb; const float* beb = BE + cb; float* lfb = Lf + cb * 64 + s; unsigned char* qkb = lds + O_QKM + cb * RT_ + s * 2;
#pragma unroll
      for (int i = 0; i < 16; ++i) { const int c = cb + CRC(i); const float dec = __expf(fminf(gcb[CRC(i)] - gs, 0.f));
          if (!isQ) lfb[CRC(i) * 64] = (c > s) ? beb[CRC(i)] * acc[i] * dec : 0.f;
          else *(unsigned short*)(qkb + CRC(i) * RT_) = f2bf((c >= s) ? acc[i] * dec : 0.f); } }
    __syncthreads();
    }
    *(uint4*)(gb + tid * 16) = *(const uint4*)(lds + O_QKM + (tid >> 3) * RT_ + (tid & 7) * 16);
    if (w == 0) { const int g4 = lane >> 4, j = lane & 15; float t[16];
        const float* Lb = Lf + (16 * g4) * 64 + 16 * g4;
#pragma unroll
        for (int i = 0; i < 16; ++i) { float a = (i == j) ? 1.f : 0.f;
#pragma unroll
            for (int k = 0; k < i; ++k) a -= Lb[i * 64 + k] * t[k];
            t[i] = a; if ((i & 3) == 3) asm volatile("" ::: "memory"); }
        asm volatile("s_waitcnt lgkmcnt(0)" ::: "memory");
#pragma unroll
        for (int i = 0; i < 16; ++i) Lf[(16 * g4 + i) * 64 + 16 * g4 + j] = t[i]; }
    __syncthreads();
#pragma unroll 1
    for (int I = 1; I < 4; ++I) { const int c = tid & 63, r = tid >> 6, n = 16 * I;
        if (c < n) { float a0 = 0.f, a1 = 0.f;
#pragma unroll 8
            for (int k = 0; k < n; ++k) { const float tm = Lf[k * 64 + c]; a0 -= Lf[(n + r) * 64 + k] * tm; a1 -= Lf[(n + r + 8) * 64 + k] * tm; }
            RTm[r * 64 + c] = a0; RTm[(r + 8) * 64 + c] = a1; }
        __syncthreads();
        if (c < n) { float b0 = 0.f, b1 = 0.f;
#pragma unroll
            for (int k = 0; k < 16; ++k) { const float rk = RTm[k * 64 + c]; b0 += Lf[(n + r) * 64 + n + k] * rk; b1 += Lf[(n + r + 8) * 64 + n + k] * rk; }
            Lf[(n + r) * 64 + c] = b0; Lf[(n + r + 8) * 64 + c] = b1; }
        __syncthreads(); }
    }
#pragma unroll 1
    for (int rep4 = 0; rep4 < ((PREP_REP & 4) ? 2 : 1); ++rep4) {
    __syncthreads();
    { const int c = tid >> 3, s0 = (tid & 7) * 8; float u[8], ww[8];
#pragma unroll
      for (int q = 0; q < 8; ++q) { const float t = Lf[c * 64 + s0 + q] * BE[s0 + q]; u[q] = t; ww[q] = t * EG[s0 + q]; }
      *(uint4*)(lds + O_TMU + c * RT_ + s0 * 2) = make_uint4(pk_bf16c(u[0], u[1]), pk_bf16c(u[2], u[3]), pk_bf16c(u[4], u[5]), pk_bf16c(u[6], u[7]));
      *(uint4*)(lds + O_TMW + c * RT_ + s0 * 2) = make_uint4(pk_bf16c(ww[0], ww[1]), pk_bf16c(ww[2], ww[3]), pk_bf16c(ww[4], ww[5]), pk_bf16c(ww[6], ww[7])); }
    __syncthreads();
    { f32x16 z;
#pragma unroll
      for (int i = 0; i < 16; ++i) z[i] = 0.f;
      const f32x16 ut = mm32<4>(z, lds + O_VT + (w >> 1) * 32 * RT_, RT_, lds + O_TMU + (w & 1) * 32 * RT_, RT_, lane);
      *(uint4*)(ga + tid * 32) = make_uint4(pk_bf16c(ut[0], ut[1]), pk_bf16c(ut[2], ut[3]), pk_bf16c(ut[4], ut[5]), pk_bf16c(ut[6], ut[7]));
      *(uint4*)(ga + tid * 32 + 16) = make_uint4(pk_bf16c(ut[8], ut[9]), pk_bf16c(ut[10], ut[11]), pk_bf16c(ut[12], ut[13]), pk_bf16c(ut[14], ut[15]));
      const f32x16 wa = mm32<4>(z, lds + O_TMW + (w >> 2) * 32 * RT_, RT_, lds + O_KT + (w & 3) * 32 * RT_, RT_, lane);
      unsigned char* wb = lds + O_W + ((w >> 2) * 32 + 4 * hi) * RK + ((w & 3) * 32 + l31) * 2;
#pragma unroll
      for (int i = 0; i < 16; ++i) *(unsigned short*)(wb + CRC(i) * RK) = f2bf(wa[i]); }
    __syncthreads();
#pragma unroll
    for (int i = 0; i < 2; ++i) { const int pc = tid + i * 512; *(uint4*)(ga + 16384 + pc * 16) = *(const uint4*)(lds + O_W + (pc >> 4) * RK + (pc & 15) * 16); }
    }
}
__device__ __forceinline__ uint4 ldc16(const unsigned char* p) {
    const unsigned long long a = __hip_atomic_load((const unsigned long long*)p, __ATOMIC_RELAXED, __HIP_MEMORY_SCOPE_AGENT);
    const unsigned long long b = __hip_atomic_load((const unsigned long long*)p + 1, __ATOMIC_RELAXED, __HIP_MEMORY_SCOPE_AGENT);
    return make_uint4((unsigned)a, (unsigned)(a >> 32), (unsigned)b, (unsigned)(b >> 32)); }
constexpr int O_OB2 = 90112;
__device__ __forceinline__ void scan_epilogue(const Params& p, const unsigned char* lds, int b, int h, int t0, uint4 z0, uint4 z1, const float (&gg)[16]) {
    const int tid = threadIdx.x; const int s = tid >> 3, dg = tid & 7;
    const uint4 q0 = *(const uint4*)(lds + O_OB2 + s * RK + dg * 32), q1 = *(const uint4*)(lds + O_OB2 + s * RK + dg * 32 + 16);
    const unsigned qq[8] = {q0.x, q0.y, q0.z, q0.w, q1.x, q1.y, q1.z, q1.w};
    float o[16]; float ss = 0.f;
#pragma unroll
    for (int q = 0; q < 8; ++q) { o[2 * q] = __uint_as_float(qq[q] << 16); o[2 * q + 1] = __uint_as_float(qq[q] & 0xffff0000u); }
#pragma unroll
    for (int c = 0; c < 16; ++c) ss += o[c] * o[c];
    ss += __shfl_xor(ss, 1); ss += __shfl_xor(ss, 2); ss += __shfl_xor(ss, 4);
    const float rstd = __builtin_amdgcn_rsqf(ss * (1.0f / 128.0f) + 1e-6f);
    const size_t tok = (size_t)b * SEQ + t0 + s;
    const unsigned zz[8] = {z0.x, z0.y, z0.z, z0.w, z1.x, z1.y, z1.z, z1.w};
    unsigned ow[8];
#pragma unroll
    for (int q = 0; q < 8; ++q) { const float za = __uint_as_float(zz[q] << 16), zb = __uint_as_float(zz[q] & 0xffff0000u);
        const float sa = za * __builtin_amdgcn_rcpf(1.f + __builtin_amdgcn_exp2f(-1.4426950408889634f * za)), sb = zb * __builtin_amdgcn_rcpf(1.f + __builtin_amdgcn_exp2f(-1.4426950408889634f * zb));
        const float va = o[2 * q] * rstd * gg[2 * q] * sa, vb = o[2 * q + 1] * rstd * gg[2 * q + 1] * sb;
        ow[q] = pk_bf16(va, vb); }
    unsigned short* dst = (unsigned short*)(p.ws + WS_HB) + tok * 1024 + h * 128 + dg * 16;
    *(uint4*)dst = make_uint4(ow[0], ow[1], ow[2], ow[3]); *(uint4*)(dst + 8) = make_uint4(ow[4], ow[5], ow[6], ow[7]);
}
__device__ void scan_unit(const Params& p, unsigned char* lds, int bh) {
    const int tid = threadIdx.x, lane = tid & 63, w = tid >> 6, hi = lane >> 5, l31 = lane & 31, b = bh >> 2, h = bh & 3;
    const float* GC = (const float*)(lds + O_G); const float* EG = GC + 128; const float* DL = GC + 192;
    f32x16 Sacc[2];
#pragma unroll
    for (int i = 0; i < 16; ++i) { Sacc[0][i] = 0.f; Sacc[1][i] = 0.f; }
    for (int i = tid; i < 34816 / 16; i += 512) ((uint4*)(lds + O_ST))[i] = make_uint4(0u, 0u, 0u, 0u);
    uint4 rU0, rU1, rW0, rW1, rQ0, rQ1, rK0, rK1, rM, rG = make_uint4(0u, 0u, 0u, 0u), rZ0, rZ1;
    const int es = tid >> 3, edg = tid & 7;
#define SCAN_LOAD(chn) do { const unsigned char* ga_ = prepA(p, bh, (chn)); const unsigned char* gb_ = prepB(p, bh, (chn));                          \
        rU0 = *(const uint4*)(ga_ + tid * 32); rU1 = *(const uint4*)(ga_ + tid * 32 + 16);                                                           \
        rW0 = *(const uint4*)(ga_ + 16384 + tid * 16); rW1 = *(const uint4*)(ga_ + 16384 + (tid + 512) * 16);                                        \
        rQ0 = *(const uint4*)(ga_ + 32768 + tid * 16); rQ1 = *(const uint4*)(ga_ + 32768 + (tid + 512) * 16);                                        \
        rK0 = *(const uint4*)(ga_ + 49152 + tid * 16); rK1 = *(const uint4*)(ga_ + 49152 + (tid + 512) * 16);                                        \
        rM = *(const uint4*)(gb_ + tid * 16); if (tid < 32) rG = *(const uint4*)(gb_ + 8192 + tid * 16);                                             \
        { const unsigned short* zp_ = (const unsigned short*)(p.ws + WS_ZG) + ((size_t)b * SEQ + (chn) * 64 + es) * 3072 + h * 128 + edg * 16;       \
          rZ0 = *(const uint4*)zp_; rZ1 = *(const uint4*)(zp_ + 8); } } while (0)
    f32x16 ut; uint4 zc0, zc1, zp0 = make_uint4(0u, 0u, 0u, 0u), zp1 = zp0;
    float gg[16];
#pragma unroll
    for (int q = 0; q < 16; ++q) gg[q] = p.g_gdn_out[edg * 16 + q];
#define SCAN_FILL() do { const int p0_ = tid, p1_ = tid + 512;                                                                                       \
        { const unsigned uu_[8] = {rU0.x, rU0.y, rU0.z, rU0.w, rU1.x, rU1.y, rU1.z, rU1.w};                                                          \
          _Pragma("unroll") for (int q = 0; q < 8; ++q) { ut[2 * q] = __uint_as_float(uu_[q] << 16); ut[2 * q + 1] = __uint_as_float(uu_[q] & 0xffff0000u); } } \
        *(uint4*)(lds + O_W + (p0_ >> 4) * RK + (p0_ & 15) * 16) = rW0; *(uint4*)(lds + O_W + (p1_ >> 4) * RK + (p1_ & 15) * 16) = rW1;              \
        *(uint4*)(lds + O_QN + (p0_ >> 4) * RK + (p0_ & 15) * 16) = rQ0; *(uint4*)(lds + O_QN + (p1_ >> 4) * RK + (p1_ & 15) * 16) = rQ1;            \
        *(uint4*)(lds + O_KT + (p0_ >> 3) * RT_ + (p0_ & 7) * 16) = rK0; *(uint4*)(lds + O_KT + (p1_ >> 3) * RT_ + (p1_ & 7) * 16) = rK1;            \
        *(uint4*)(lds + O_QKM + (tid >> 3) * RT_ + (tid & 7) * 16) = rM;                                                                             \
        if (tid < 32) *(uint4*)(lds + O_G + 512 + tid * 16) = rG;                                                                                    \
        zc0 = rZ0; zc1 = rZ1; } while (0)
    SCAN_LOAD(0);
    SCAN_FILL();
    SCAN_LOAD(1);
    __syncthreads();
#pragma unroll 1
    for (int ch = 0; ch < SEQ / 64; ++ch) {
        if (ch > 0) scan_epilogue(p, lds, b, h, (ch - 1) * 64, zp0, zp1, gg);
        f32x16 oacc;
        { f32x16 z;
#pragma unroll
          for (int i = 0; i < 16; ++i) z[i] = 0.f;
          const f32x16 acc = mm32<8>(z, lds + O_ST + (w >> 1) * 32 * RK, RK, lds + O_W + (w & 1) * 32 * RK, RK, lane);
          const int c = (w & 1) * 32 + l31; const float dl = DL[c]; unsigned char* vb_ = lds + O_VNT + ((w >> 1) * 32 + 4 * hi) * RT_ + c * 2;
#pragma unroll
          for (int i = 0; i < 16; ++i) { const float vn = ut[i] - acc[i];
              *(unsigned short*)(vb_ + CRC(i) * RT_) = f2bf(vn); *(unsigned short*)(vb_ + (O_VNTD - O_VNT) + CRC(i) * RT_) = f2bf(vn * dl); }
          oacc = mm32<8>(z, lds + O_QN + (w >> 2) * 32 * RK, RK, lds + O_ST + (w & 3) * 32 * RK, RK, lane);
          { const float* egb = EG + (w >> 2) * 32 + 4 * hi;
#pragma unroll
            for (int i = 0; i < 16; ++i) oacc[i] *= egb[CRC(i)]; }
          const float gam = EG[63];
#pragma unroll
          for (int j = 0; j < 2; ++j)
#pragma unroll
              for (int i = 0; i < 16; ++i) Sacc[j][i] *= gam; }
        __syncthreads();
        oacc = mm32<4>(oacc, lds + O_QKM + (w >> 2) * 32 * RT_, RT_, lds + O_VNT + (w & 3) * 32 * RT_, RT_, lane);
#pragma unroll
        for (int j = 0; j < 2; ++j) Sacc[j] = mm32<4>(Sacc[j], lds + O_VNTD + (w >> 1) * 32 * RT_, RT_, lds + O_KT + ((w & 1) * 2 + j) * 32 * RT_, RT_, lane);
        __syncthreads();
#pragma unroll
        for (int j = 0; j < 2; ++j) { unsigned char* sb_ = lds + O_ST + ((w >> 1) * 32 + 4 * hi) * RK + (((w & 1) * 2 + j) * 32 + l31) * 2;
#pragma unroll
            for (int i = 0; i < 16; ++i) *(unsigned short*)(sb_ + CRC(i) * RK) = f2bf(Sacc[j][i]); }
        { unsigned char* ob_ = lds + O_OB2 + ((w >> 2) * 32 + 4 * hi) * RK + ((w & 3) * 32 + l31) * 2;
#pragma unroll
          for (int i = 0; i < 16; ++i) *(unsigned short*)(ob_ + CRC(i) * RK) = f2bf(oacc[i]); }
        zp0 = zc0; zp1 = zc1;
        if (ch + 1 < SEQ / 64) { SCAN_FILL(); if (ch + 2 < SEQ / 64) SCAN_LOAD(ch + 2); }
        __syncthreads();
    }
    scan_epilogue(p, lds, b, h, (SEQ / 64 - 1) * 64, zp0, zp1, gg);
    __syncthreads();
#undef SCAN_LOAD
#undef SCAN_FILL
}
}

__device__ __forceinline__ void attn_phase(const Params& p, unsigned char* lds8, int rep) {
    using namespace fox;
    typedef BlockRef<bf16, bf16> Ref;
    char* lds = (char*)lds8;
    volatile int* slot = (volatile int*)(lds + SLOT_OFF);
    unsigned* ctr = (unsigned*)(p.ws + WS_CTRL) + rep;
    const int total = NBATCH * NHEAD * (SEQ / QB);
    const bf16* FQ = (const bf16*)(p.ws + WS_FQKV); const bf16* FK = FQ + (size_t)MTOK * 512; const bf16* FV = FK + (size_t)MTOK * 512;
    auto mkref = [&](int L) { Ref r; const int qb = (SEQ / QB - 1) - (L >> 5), bh = L & 31, b = bh >> 2, h = bh & 3;
        r.Q = FQ + ((size_t)bh * SEQ + (size_t)qb * QB) * D; r.K = FK + (size_t)bh * SEQ * D; r.V = FV + (size_t)bh * SEQ * D;
        r.KB = (const float*)(p.ws + WS_KBIAS) + (size_t)bh * SEQ;
        r.O = (bf16*)(p.ws + WS_HB) + ((size_t)b * SEQ + (size_t)qb * QB) * OSTR + 512 + h * 128;
        r.Z = (const unsigned short*)(p.ws + WS_ZG) + ((size_t)b * SEQ + (size_t)qb * QB) * ZSTR + 512 + h * 128;
        r.P0 = qb * QB; r.JLO = ((const int*)(p.ws + WS_JLO))[bh * 32 + qb]; return r; };
    int it = 0;
    __syncthreads();
    if (threadIdx.x == 0) slot[0] = (int)atomicAdd(ctr, 1u);
    __syncthreads();
    int L = __builtin_amdgcn_readfirstlane(slot[0]);
    if (L >= total) return;
    Ref cur = mkref(L);
    Seam<bf16> S;
    causal_swa_prime<bf16, bf16>(cur, 1 << 20, lds, S);
    for (;;) {
        ++it;
        if (threadIdx.x == 0) slot[it & 1] = (int)atomicAdd(ctr, 1u);
        __syncthreads();
        const int Ln = __builtin_amdgcn_readfirstlane(slot[it & 1]);
        const bool last = Ln >= total;
        const Ref nxt = last ? cur : mkref(Ln);
        causal_swa_block<bf16, bf16>(cur, nxt, SEQ, 1 << 20, lds, S);
        if (last) break;
        cur = nxt;
    }
    __syncthreads();
}

__device__ __forceinline__ void run_p2(const Params& p, unsigned char* lds) {
    phase_cumsum(p, lds);
    __syncthreads();
    pg8::Gemm g{(const pg8::bf16_t*)(p.ws + WS_HB), (const pg8::bf16_t*)(p.ws + WS_WIN_T), MTOK, NPROJ, 1024, 1024, 1024};
    pg8::StaticOrder S; S.init(MTOK, NPROJ, gridDim.x, blockIdx.x);
    pg8::EpiProj E{(pg8::bf16_t*)(p.ws + WS_GQKV), (pg8::bf16_t*)(p.ws + WS_FQKV), (pg8::bf16_t*)(p.ws + WS_ZG), p.g_q_fox, p.g_k_fox, (PG8_LAS float*)((PG8_LAS unsigned char*)lds + GEMM_X_OFF)};
    pg8::gemm_phase<pg8::EpiProj, pg8::StaticOrder, true, true>((PG8_LAS unsigned char*)lds, g, S, E);
}
__device__ __forceinline__ void run_p3a(const Params& p, unsigned char* lds) {
    { const int h0 = blockIdx.x & 3; float* cw = (float*)(lds + gdn2::O_CW);
      for (int i = threadIdx.x; i < 1536; i += 512) { const int pt = i >> 7, d = i & 127, part = pt >> 2, tap = pt & 3; cw[i] = p.conv_w[tap * 1536 + part * 512 + h0 * 128 + d]; } }
    gdn2::RawRegs R; { const int L0 = blockIdx.x; if (L0 < 4096) gdn2::stage_load(p, R, (L0 & 31) >> 2, L0 & 3, (L0 >> 5) * 64); }
#pragma unroll 1
    for (int L = blockIdx.x; L < 4096; L += gridDim.x) { const int Ln = L + gridDim.x; gdn2::prep_unit(p, lds, L & 31, L >> 5, R, Ln < 4096, Ln & 31, Ln >> 5); }
    __syncthreads();
}
__device__ __forceinline__ void run_p3(const Params& p, unsigned char* lds, int rep) {
    if (PH_MASK & 64) { if (blockIdx.x < 32) { gdn2::scan_unit(p, lds, blockIdx.x); if (PREP_REP & 8) gdn2::scan_unit(p, lds, blockIdx.x); } }
    if (PH_MASK & 8) attn_phase(p, lds, rep);
}
__device__ __forceinline__ void run_p4(const Params& p, unsigned char* lds) {
    pg8::Gemm g{(const pg8::bf16_t*)(p.ws + WS_HB), (const pg8::bf16_t*)(p.ws + WS_WO2_T), MTOK, 1024, 1024, 1024, 1024};
    pg8::StaticOrder S; S.init(MTOK, 1024, gridDim.x, blockIdx.x);
    pg8::EpiMerge E{(pg8::bf16_t*)(p.ws + WS_FQKV), (const pg8::bf16_t*)(p.ws + WS_ZG) + 1024};
    pg8::gemm_phase<pg8::EpiMerge, pg8::StaticOrder, true, true>((PG8_LAS unsigned char*)lds, g, S, E);
}
__device__ __forceinline__ void run_p5(const Params& p, unsigned char* lds) {
    pg8::Gemm g{(const pg8::bf16_t*)(p.ws + WS_FQKV), (const pg8::bf16_t*)(p.ws + WS_WOUT2_T), MTOK, 1024, 1024, 1024, 2048};
    pg8::StaticOrder S; S.init(MTOK, 1024, gridDim.x, blockIdx.x);
    pg8::EpiOut E{p.x, p.out, (const float*)(p.ws + WS_MOD)};
    pg8::gemm_phase<pg8::EpiOut, pg8::StaticOrder, true, true>((PG8_LAS unsigned char*)lds, g, S, E);
}

__global__ void __launch_bounds__(512, 2) fwd_kernel(Params p, int ph_lo, int ph_hi) {
    extern __shared__ __attribute__((aligned(16))) unsigned char lds[];
    cg::grid_group grid = cg::this_grid();
#define GSYNC() do { grid.sync(); } while (0)
#define IN(ph) (ph_lo <= (ph) && (ph) < ph_hi)
#define SEAM(ph) do { if (IN(ph) && (ph) + 1 < ph_hi) GSYNC(); } while (0)
    if (IN(0)) { if (PH_MASK & 1) phase_prologue(p, lds); }
#if REPEAT_PH == 0
    GSYNC(); phase_prologue(p, lds);
#endif
    SEAM(0);
    if (IN(1)) { if (PH_MASK & 2) phase_prepass(p, lds); }
#if REPEAT_PH == 1
    GSYNC(); phase_prepass(p, lds);
#endif
    SEAM(1);
    if (IN(2) && (PH_MASK & 4)) run_p2(p, lds);
#if REPEAT_PH == 2
    GSYNC(); run_p2(p, lds);
#endif
    SEAM(2);
    if (IN(3)) { run_p3a(p, lds); GSYNC(); run_p3(p, lds, 0); }
#if REPEAT_PH == 3
    GSYNC(); run_p3(p, lds, 1);
#endif
#if REPEAT_PH == 6
    GSYNC(); run_p3a(p, lds);
#endif
    SEAM(3);
    if (IN(4) && (PH_MASK & 16)) run_p4(p, lds);
#if REPEAT_PH == 4
    GSYNC(); run_p4(p, lds);
#endif
    SEAM(4);
    if (IN(5) && (PH_MASK & 32)) run_p5(p, lds);
#if REPEAT_PH == 5
    GSYNC(); run_p5(p, lds);
#endif
}

extern "C" void kernel_launch(void* const* d_in, const int* in_sizes, int n_in, void* d_out, int out_size, void* d_ws, size_t ws_size, hipStream_t stream) {
    static int grid_blocks = 0;
    if (grid_blocks == 0) {
        if (n_in != 16 || out_size != MTOK * DM || ws_size < WS_END) { fprintf(stderr, "kernel_launch: unexpected shapes (n_in %d out %d ws %zu need %zu)\n", n_in, out_size, ws_size, (size_t)WS_END); grid_blocks = -1; return; }
        int dev = 0, cus = 0, per_cu = 0;
        (void)hipGetDevice(&dev); (void)hipDeviceGetAttribute(&cus, hipDeviceAttributeMultiprocessorCount, dev);
        if (hipFuncSetAttribute((const void*)fwd_kernel, hipFuncAttributeMaxDynamicSharedMemorySize, LDS_TOTAL) != hipSuccess) fprintf(stderr, "kernel_launch: hipFuncSetAttribute failed\n");
        if (hipOccupancyMaxActiveBlocksPerMultiprocessor(&per_cu, (const void*)fwd_kernel, 512, LDS_TOTAL) != hipSuccess || per_cu < 1) { fprintf(stderr, "kernel_launch: occupancy query says %d\n", per_cu); per_cu = 1; }
        (void)hipGetLastError();
        grid_blocks = cus - cus % 32;
        if (grid_blocks <= 0) grid_blocks = 256;
    }
    if (grid_blocks < 0) return;
    Params p{};
    p.x = (const float*)d_in[0]; p.c = (const float*)d_in[1]; p.w_ada = (const float*)d_in[2]; p.b_ada = (const float*)d_in[3]; p.g_norm = (const float*)d_in[4]; p.w_in = (const float*)d_in[5];
    p.conv_w = (const float*)d_in[6]; p.A_log = (const float*)d_in[7]; p.dt_bias = (const float*)d_in[8]; p.g_gdn_out = (const float*)d_in[9]; p.g_q_fox = (const float*)d_in[10]; p.g_k_fox = (const float*)d_in[11];
    p.b_f = (const float*)d_in[12]; p.w_o_gdn = (const float*)d_in[13]; p.w_o_fox = (const float*)d_in[14]; p.w_out = (const float*)d_in[15];
    p.out = (float*)d_out; p.ws = (unsigned char*)d_ws;
#ifdef MULTI_LAUNCH
    for (int ph = 0; ph < 6; ++ph) { int lo = ph, hi = ph + 1; void* args[] = {&p, &lo, &hi};
        hipError_t e = hipLaunchCooperativeKernel((const void*)fwd_kernel, dim3(grid_blocks), dim3(512), args, LDS_TOTAL, stream);
        if (e != hipSuccess) fprintf(stderr, "launch %d failed: %s\n", ph, hipGetErrorString(e)); }
#else
    int lo = 0, hi = 6; void* args[] = {&p, &lo, &hi};
    hipError_t e = hipLaunchCooperativeKernel((const void*)fwd_kernel, dim3(grid_blocks), dim3(512), args, LDS_TOTAL, stream);
    if (e != hipSuccess) fprintf(stderr, "cooperative launch failed: %s (grid %d)\n", hipGetErrorString(e), grid_blocks);
#endif
}
```

```cpp
#include <hip/hip_runtime.h>
#include <hip/hip_bf16.h>
#include <hip/hip_cooperative_groups.h>
#include <cstdio>
#include <cstdint>
namespace cg = cooperative_groups;
#ifndef REPEAT_PH
#define REPEAT_PH -1
#endif
#ifndef PH_MASK
#define PH_MASK 127
#endif

constexpr int NBATCH = 8, SEQ = 8192, DM = 1024, MTOK = NBATCH * SEQ, NHEAD = 4, HDIM = 128;
constexpr int DIN = 6156, NPROJ = 6144;
constexpr size_t WS_CTRL = 0;
constexpr size_t WS_MOD = 4096;
constexpr size_t WS_WSMALL = WS_MOD + (size_t)NBATCH * 3072 * 4;
constexpr size_t WS_WIN_T = WS_WSMALL + 12 * 1024 * 4;
constexpr size_t WS_WO2_T = WS_WIN_T + (size_t)NPROJ * 1024 * 2;
constexpr size_t WS_WOUT2_T = WS_WO2_T + (size_t)2048 * 512 * 2;
constexpr size_t WS_GDEC = WS_WOUT2_T + (size_t)1024 * 2048 * 2;
constexpr size_t WS_BETA = WS_GDEC + (size_t)MTOK * 16;
constexpr size_t WS_LOGF = WS_BETA + (size_t)MTOK * 16;
constexpr size_t WS_KBIAS = WS_LOGF + (size_t)MTOK * 16;
constexpr size_t WS_HB = WS_KBIAS + (size_t)MTOK * 16;
constexpr size_t WS_GQKV = WS_HB + (size_t)MTOK * 1024 * 2;
constexpr size_t WS_FQKV = WS_GQKV + (size_t)MTOK * 1536 * 2;
constexpr size_t WS_ZG = WS_FQKV + (size_t)3 * MTOK * 512 * 2;
constexpr size_t WS_PREPB = WS_ZG + (size_t)MTOK * 3072 * 2;
constexpr size_t WS_JLO = WS_PREPB + (size_t)4096 * 8704;
constexpr size_t WS_END = WS_JLO + 4096;
static_assert(WS_WIN_T % 256 == 0 && WS_HB % 256 == 0 && WS_ZG % 256 == 0, "align");

struct Params {
    const float* x; const float* c; const float* w_ada; const float* b_ada; const float* g_norm; const float* w_in;
    const float* conv_w; const float* A_log; const float* dt_bias; const float* g_gdn_out; const float* g_q_fox; const float* g_k_fox;
    const float* b_f; const float* w_o_gdn; const float* w_o_fox; const float* w_out;
    float* out; unsigned char* ws;
};

__device__ __forceinline__ float bf2f(unsigned short u) { return __uint_as_float((unsigned)u << 16); }
typedef __bf16 bf16v2_t __attribute__((ext_vector_type(2)));
typedef float f32v2_t __attribute__((ext_vector_type(2)));
__device__ __forceinline__ unsigned pk_bf16(float lo, float hi) { unsigned r; asm volatile("v_cvt_pk_bf16_f32 %0, %1, %2" : "=v"(r) : "v"(lo), "v"(hi)); return r; }
__device__ __forceinline__ unsigned pk_bf16c(float lo, float hi) { const bf16v2_t r = __builtin_convertvector((f32v2_t){lo, hi}, bf16v2_t); return __builtin_bit_cast(unsigned, r); }
__device__ __forceinline__ float sigmoidf_(float v) { return 1.f / (1.f + __expf(-v)); }
__device__ __forceinline__ float siluf_(float v) { return v / (1.f + __expf(-v)); }
__device__ __forceinline__ float softplusf_(float v) { return fmaxf(v, 0.f) + log1pf(__expf(-fabsf(v))); }
#define WG_BARRIER() do { asm volatile("s_waitcnt vmcnt(0) lgkmcnt(0)" ::: "memory"); __builtin_amdgcn_s_barrier(); asm volatile("" ::: "memory"); } while (0)

namespace pg8 {
#define PG8_LAS __attribute__((address_space(3)))
typedef unsigned short bf16_t;
typedef short bf16x8 __attribute__((ext_vector_type(8)));
typedef float f32x4 __attribute__((ext_vector_type(4)));
typedef unsigned u32x4 __attribute__((ext_vector_type(4)));
constexpr int BM = 256, BK = 64, HALF = 128, HTB = HALF * BK * 2  , STAGE_BYTES = 8 * HTB, NXCD = 8, WGM = 8;

__host__ __device__ __forceinline__ int lds_byte(int r, int c) { const int st = (r >> 4) * 2 + (c >> 5), rr = r & 15, cc = c & 31, ob = rr * 64 + cc * 2; return st * 1024 + (ob ^ (((ob >> 9) & 1) << 5)); }
__host__ __device__ __forceinline__ void stage_rc(int b, int& R, int& C) { const int st = b / 1024, sb = b % 1024, swz = sb ^ (((sb >> 9) & 1) << 5); R = (st >> 1) * 16 + swz / 64; C = (st & 1) * 32 + (swz % 64) / 2; }
__host__ __device__ __forceinline__ int perm32(int rho) { const int n = rho >> 4, i = rho & 15; return 8 * (i >> 2) + 4 * n + (i & 3); }

struct Unit { int pm, pn; };
struct Gemm { const bf16_t* A; const bf16_t* Bt; int M, N, K, lda, ldb; };

struct StaticOrder {
    int nM, nN, nwg, G, c;
    __host__ __device__ void init(int M, int N, int G_, int c_) { nM = M / BM; nN = N / BM; nwg = nM * nN; G = G_; c = c_; }
    __host__ __device__ bool next(int i, Unit& u) const {
        const long L = (long)i * G + c; if (L >= nwg) return false;
        int wgid = (int)L; { const int q = nwg / NXCD, r = nwg % NXCD, xcd = wgid % NXCD, off = wgid / NXCD; wgid = (xcd < r ? xcd * (q + 1) : r * (q + 1) + (xcd - r) * q) + off; }
        const int nig = WGM * nN, gid = wgid / nig, fm = gid * WGM, gsz = (nM - fm) < WGM ? (nM - fm) : WGM;
        u.pm = fm + ((wgid % nig) % gsz); u.pn = (wgid % nig) / gsz; return true;
    }
    __device__ __forceinline__ void a_ready(const Unit&) const {}
    __device__ __forceinline__ void done(const Unit&) const {}
};

typedef unsigned u32x4 __attribute__((ext_vector_type(4)));
__device__ __forceinline__ u32x4 pack8bf(const f32x4 v0, const f32x4 v1) { u32x4 w; w.x = pk_bf16(v0[0], v0[1]); w.y = pk_bf16(v0[2], v0[3]); w.z = pk_bf16(v1[0], v1[1]); w.w = pk_bf16(v1[2], v1[3]); return w; }
struct EpiProj {
    static constexpr bool PERM = true, AFTER_DRAIN = false, MIDHOOK = false;
    bf16_t* gqkv; bf16_t* fqkv; bf16_t* zg; const float* gq; const float* gk; PG8_LAS float* X;
    __device__ __forceinline__ void operator()(const f32x4 (&acc)[2][2][4][2], const Unit& u, int wr, int wc, int fr, int fq) const {
        const int pn = u.pn, row0 = u.pm * BM + wr * 64 + fr, cl = wc * 32 + 8 * fq;
        const bool nrm = pn >= 8 && pn < 12;
        if (nrm) {
#pragma unroll
            for (int ai = 0; ai < 2; ++ai)
#pragma unroll
                for (int m = 0; m < 4; ++m)
#pragma unroll
                    for (int bj = 0; bj < 2; ++bj) { const f32x4 a = acc[ai][bj][m][0], b = acc[ai][bj][m][1];
                        float s = (a[0] * a[0] + a[1] * a[1]) + (a[2] * a[2] + a[3] * a[3]) + (b[0] * b[0] + b[1] * b[1]) + (b[2] * b[2] + b[3] * b[3]);
                        s += __shfl_xor(s, 16); s += __shfl_xor(s, 32);
                        if (fq == 0) X[((ai * HALF + wr * 64 + m * 16 + fr) * 2 + bj) * 4 + wc] = s; asm volatile("" ::: "memory"); }
            asm volatile("s_waitcnt lgkmcnt(0)" ::: "memory"); __builtin_amdgcn_s_barrier(); asm volatile("" ::: "memory");
        }
        bf16_t* base; size_t bstride, bjstride; int ld;
        if (pn >= 8 && pn < 14) { base = fqkv + (size_t)((pn - 8) >> 1) * ((size_t)MTOK * 512) + (size_t)((pn & 1) * 2) * SEQ * 128 + cl; bstride = (size_t)4 * SEQ * 128; bjstride = (size_t)SEQ * 128; ld = 128; }
        else if (pn < 6) { base = gqkv + pn * 256 + cl; bstride = (size_t)SEQ * 1536; bjstride = 128; ld = 1536; }
        else { const int c0 = pn < 8 ? (pn - 6) * 256 : (pn < 16 ? 512 + (pn - 14) * 256 : 1024 + (pn - 16) * 256); base = zg + c0 + cl; bstride = (size_t)SEQ * 3072; bjstride = 128; ld = 3072; }
        const float* gv = (pn < 10) ? gq : gk;
        base += (size_t)((u.pm * BM) >> 13) * bstride;
        const int t0 = (row0 & 8191);
#pragma unroll
        for (int ai = 0; ai < 2; ++ai)
#pragma unroll
            for (int m = 0; m < 4; ++m) { bf16_t* rowp = base + (size_t)(t0 + ai * HALF + m * 16) * ld;
#pragma unroll
                for (int bj = 0; bj < 2; ++bj) { float r = 1.f; f32x4 g0 = {1.f, 1.f, 1.f, 1.f}, g1 = {1.f, 1.f, 1.f, 1.f};
                    if (nrm) { g0 = *(const f32x4*)(gv + cl); g1 = *(const f32x4*)(gv + cl + 4); const f32x4 t4 = *(const PG8_LAS f32x4*)(X + ((ai * HALF + wr * 64 + m * 16 + fr) * 2 + bj) * 4); r = 1.0f / sqrtf(((t4[0] + t4[1]) + (t4[2] + t4[3])) * (1.0f / 128.0f) + 1e-6f); }
                    *(u32x4*)(rowp + bj * bjstride) = pack8bf(acc[ai][bj][m][0] * (g0 * r), acc[ai][bj][m][1] * (g1 * r)); }
                asm volatile("" ::: "memory"); }
    }
};
struct EpiGate {
    static constexpr bool PERM = true, AFTER_DRAIN = false, MIDHOOK = false;
    bf16_t* G; const bf16_t* gate; int add;
    __device__ __forceinline__ void operator()(const f32x4 (&acc)[2][2][4][2], const Unit& u, int wr, int wc, int fr, int fq) const {
        const int row0 = u.pm * BM + wr * 64 + fr, col0 = u.pn * BM + wc * 32 + 8 * fq;
#pragma unroll
        for (int ai = 0; ai < 2; ++ai)
#pragma unroll
            for (int m = 0; m < 4; ++m) { const size_t gr = (size_t)(row0 + ai * HALF + m * 16);
#pragma unroll
                for (int bj = 0; bj < 2; ++bj) { const u32x4 gw = *(const u32x4*)(gate + gr * 3072 + col0 + bj * HALF);
                    f32x4 s0, s1;
                    s0[0] = __uint_as_float(gw.x << 16); s0[1] = __uint_as_float(gw.x & 0xffff0000u); s0[2] = __uint_as_float(gw.y << 16); s0[3] = __uint_as_float(gw.y & 0xffff0000u);
                    s1[0] = __uint_as_float(gw.z << 16); s1[1] = __uint_as_float(gw.z & 0xffff0000u); s1[2] = __uint_as_float(gw.w << 16); s1[3] = __uint_as_float(gw.w & 0xffff0000u);
#pragma unroll
                    for (int i = 0; i < 4; ++i) { s0[i] = __builtin_amdgcn_rcpf(1.f + __builtin_amdgcn_exp2f(-1.4426950408889634f * s0[i])); s1[i] = __builtin_amdgcn_rcpf(1.f + __builtin_amdgcn_exp2f(-1.4426950408889634f * s1[i])); }
                    f32x4 v0 = acc[ai][bj][m][0] * s0, v1 = acc[ai][bj][m][1] * s1;
                    bf16_t* dst = G + gr * 1024 + col0 + bj * HALF;
                    if (add) { const u32x4 pw = *(const u32x4*)dst;
                        v0[0] += __uint_as_float(pw.x << 16); v0[1] += __uint_as_float(pw.x & 0xffff0000u); v0[2] += __uint_as_float(pw.y << 16); v0[3] += __uint_as_float(pw.y & 0xffff0000u);
                        v1[0] += __uint_as_float(pw.z << 16); v1[1] += __uint_as_float(pw.z & 0xffff0000u); v1[2] += __uint_as_float(pw.w << 16); v1[3] += __uint_as_float(pw.w & 0xffff0000u); }
                    *(u32x4*)dst = pack8bf(v0, v1); }
                if (m == 3) asm volatile("" ::: "memory"); }
    }
};
struct EpiMerge {
    static constexpr bool PERM = true, AFTER_DRAIN = false, MIDHOOK = true;
    bf16_t* G; const bf16_t* gate;
    __device__ __forceinline__ static void unpack8(const u32x4 gw, f32x4& s0, f32x4& s1) {
        s0[0] = __uint_as_float(gw.x << 16); s0[1] = __uint_as_float(gw.x & 0xffff0000u); s0[2] = __uint_as_float(gw.y << 16); s0[3] = __uint_as_float(gw.y & 0xffff0000u);
        s1[0] = __uint_as_float(gw.z << 16); s1[1] = __uint_as_float(gw.z & 0xffff0000u); s1[2] = __uint_as_float(gw.w << 16); s1[3] = __uint_as_float(gw.w & 0xffff0000u); }
    __device__ __forceinline__ void mid(f32x4 (&acc)[2][2][4][2], const Unit& u, int wr, int wc, int fr, int fq) const {
        const bf16_t* gp = gate + (size_t)(u.pm * BM + wr * 64 + fr) * 3072 + (u.pn * BM + wc * 32 + 8 * fq);
        asm volatile("" : "+v"(gp));
#pragma unroll
        for (int ai = 0; ai < 2; ++ai)
#pragma unroll
            for (int m = 0; m < 4; ++m) { const bf16_t* rp = gp + (size_t)(ai * HALF + m * 16) * 3072;
#pragma unroll
                for (int bj = 0; bj < 2; ++bj) { f32x4 a0, a1, f0, f1;
                    unpack8(*(const u32x4*)(rp + bj * HALF), a0, a1); unpack8(*(const u32x4*)(rp + 1024 + bj * HALF), f0, f1);
#pragma unroll
                    for (int i = 0; i < 4; ++i) {
                        a0[i] = (1.f + __builtin_amdgcn_exp2f(-1.4426950408889634f * f0[i])) * __builtin_amdgcn_rcpf(1.f + __builtin_amdgcn_exp2f(-1.4426950408889634f * a0[i]));
                        a1[i] = (1.f + __builtin_amdgcn_exp2f(-1.4426950408889634f * f1[i])) * __builtin_amdgcn_rcpf(1.f + __builtin_amdgcn_exp2f(-1.4426950408889634f * a1[i])); }
                    acc[ai][bj][m][0] *= a0; acc[ai][bj][m][1] *= a1; }
                asm volatile("" ::: "memory"); }
    }
    __device__ __forceinline__ void operator()(const f32x4 (&acc)[2][2][4][2], const Unit& u, int wr, int wc, int fr, int fq) const {
        const int row0 = u.pm * BM + wr * 64 + fr, col0 = u.pn * BM + wc * 32 + 8 * fq;
#pragma unroll
        for (int ai = 0; ai < 2; ++ai)
#pragma unroll
            for (int m = 0; m < 4; ++m) { const size_t gr = (size_t)(row0 + ai * HALF + m * 16);
#pragma unroll
                for (int bj = 0; bj < 2; ++bj) { f32x4 s0, s1; unpack8(*(const u32x4*)(gate + gr * 3072 + 1024 + col0 + bj * HALF), s0, s1);
#pragma unroll
                    for (int i = 0; i < 4; ++i) { s0[i] = __builtin_amdgcn_rcpf(1.f + __builtin_amdgcn_exp2f(-1.4426950408889634f * s0[i])); s1[i] = __builtin_amdgcn_rcpf(1.f + __builtin_amdgcn_exp2f(-1.4426950408889634f * s1[i])); }
                    *(u32x4*)(G + gr * 1024 + col0 + bj * HALF) = pack8bf(acc[ai][bj][m][0] * s0, acc[ai][bj][m][1] * s1); }
                if (m & 1) asm volatile("" ::: "memory"); }
    }
};
struct EpiOut {
    static constexpr bool PERM = true, AFTER_DRAIN = false, MIDHOOK = false;
    const float* x; float* out; const float* mod;
    __device__ __forceinline__ void operator()(const f32x4 (&acc)[2][2][4][2], const Unit& u, int wr, int wc, int fr, int fq) const {
        const int row0 = u.pm * BM + wr * 64 + fr, col0 = u.pn * BM + wc * 32 + 8 * fq;
        const float* gp = mod + (size_t)((u.pm * BM) >> 13) * 3072 + 2048 + col0;
        f32x4 gt[2][2];
#pragma unroll
        for (int bj = 0; bj < 2; ++bj) { gt[bj][0] = *(const f32x4*)(gp + bj * HALF); gt[bj][1] = *(const f32x4*)(gp + bj * HALF + 4); }
#pragma unroll
        for (int ai = 0; ai < 2; ++ai)
#pragma unroll
            for (int m = 0; m < 4; ++m) { const size_t off = (size_t)(row0 + ai * HALF + m * 16) * DM + col0;
#pragma unroll
                for (int bj = 0; bj < 2; ++bj) { const f32x4 x0 = *(const f32x4*)(x + off + bj * HALF), x1 = *(const f32x4*)(x + off + bj * HALF + 4);
                    *(f32x4*)(out + off + bj * HALF) = x0 + gt[bj][0] * acc[ai][bj][m][0]; *(f32x4*)(out + off + bj * HALF + 4) = x1 + gt[bj][1] * acc[ai][bj][m][1]; } }
    }
};

template <class Epi, class Sched, bool ALIGN_EPI = false, bool SP2 = false>
__device__ __forceinline__ void gemm_phase(PG8_LAS unsigned char* lds, const Gemm g, const Sched& S, const Epi& E) {
    const int tid = threadIdx.x, wid = __builtin_amdgcn_readfirstlane(tid >> 6), lane = tid & 63, wr = wid >> 2, wc = wid & 3, fr = lane & 15, fq = lane >> 4;
    const int K = g.K, nt = K / BK;
    unsigned voffA[2], voffB[2];
#pragma unroll
    for (int i = 0; i < 2; ++i) { int R, C; stage_rc(tid * 16 + i * 8192, R, C); const int Rb = Epi::PERM ? ((R & ~31) + perm32(R & 31)) : R;
        voffA[i] = (unsigned)(R * g.lda + C) * 2u; voffB[i] = (unsigned)(Rb * g.ldb + C) * 2u; }
    const size_t kstep = (size_t)(BK * 2);
    const size_t hstepA = (size_t)HALF * g.lda * 2, hstepB = (size_t)HALF * g.ldb * 2;
    const size_t tstepA = 2 * hstepA, tstepB = 2 * hstepB;
    const unsigned ldsw = (unsigned)wid * 1024u;
    const int aoff = lds_byte(wr * 64 + fr, fq * 8), boff = lds_byte(wc * 32 + fr, fq * 8);
#define PG8_SA(b, h) (((b) * 2 + (h)) * HTB)
#define PG8_SB(b, h) ((4 + (b) * 2 + (h)) * HTB)
#define PG8_STAGE(bufoff, gbase, voff) do { _Pragma("unroll") for (int _i = 0; _i < 2; ++_i) \
        __builtin_amdgcn_global_load_lds((const unsigned*)((const char*)(gbase) + (voff)[_i]), (PG8_LAS unsigned*)(lds + (bufoff) + ldsw + _i * 8192), 16, 0, 0); } while (0)
#define PG8_LDA(dst, b, h) do { _Pragma("unroll") for (int m = 0; m < 4; ++m) _Pragma("unroll") for (int k = 0; k < 2; ++k) dst[m][k] = *(const PG8_LAS bf16x8*)(lds + PG8_SA(b, h) + aoff + m * 2048 + k * 1024); } while (0)
#define PG8_LDB(dst, b, h) do { _Pragma("unroll") for (int n = 0; n < 2; ++n) _Pragma("unroll") for (int k = 0; k < 2; ++k) dst[n][k] = *(const PG8_LAS bf16x8*)(lds + PG8_SB(b, h) + boff + n * 2048 + k * 1024); } while (0)
#define PG8_MMA(ai, bj, At, Bt) do { __builtin_amdgcn_s_setprio(1); _Pragma("unroll") for (int m = 0; m < 4; ++m) _Pragma("unroll") for (int n = 0; n < 2; ++n) _Pragma("unroll") for (int k = 0; k < 2; ++k) \
        acc[ai][bj][m][n] = __builtin_amdgcn_mfma_f32_16x16x32_bf16(Bt[n][k], At[m][k], acc[ai][bj][m][n], 0, 0, 0); __builtin_amdgcn_s_setprio(0); } while (0)
#define PG8_WAIT_V(n) asm volatile("s_waitcnt vmcnt(" #n ")" ::: "memory")
#define PG8_WAIT_L(n) asm volatile("s_waitcnt lgkmcnt(" #n ")" ::: "memory")
#define PG8_BAR __builtin_amdgcn_s_barrier()
#define PG8_SCHED __builtin_amdgcn_sched_barrier(0)
    Unit cur, nxt; int ui = 0;
    if (!S.next(0, cur)) return;
    f32x4 acc[2][2][4][2];
#pragma unroll
    for (int a = 0; a < 2; ++a)
#pragma unroll
        for (int b = 0; b < 2; ++b)
#pragma unroll
            for (int m = 0; m < 4; ++m)
#pragma unroll
                for (int n = 0; n < 2; ++n) acc[a][b][m][n] = (f32x4){0.f, 0.f, 0.f, 0.f};
    bf16x8 At[4][2], B0[2][2], B1[2][2];
    const char* cA = (const char*)g.A + (size_t)cur.pm * tstepA; const char* cB = (const char*)g.Bt + (size_t)cur.pn * tstepB;
    S.a_ready(cur);
    if constexpr (SP2) {
        PG8_STAGE(PG8_SB(0, 0), cB, voffB); PG8_STAGE(PG8_SB(0, 1), cB + hstepB, voffB); PG8_STAGE(PG8_SA(0, 0), cA, voffA); PG8_STAGE(PG8_SA(0, 1), cA + hstepA, voffA);
        if (wr == 1) PG8_BAR;
        PG8_WAIT_V(2); PG8_BAR;
        PG8_STAGE(PG8_SB(1, 0), cB + kstep, voffB); PG8_STAGE(PG8_SA(1, 0), cA + kstep, voffA); PG8_STAGE(PG8_SB(1, 1), cB + hstepB + kstep, voffB);
        PG8_WAIT_V(6); PG8_BAR;
    } else {
        PG8_STAGE(PG8_SB(0, 0), cB, voffB); PG8_STAGE(PG8_SA(0, 0), cA, voffA); PG8_STAGE(PG8_SB(0, 1), cB + hstepB, voffB); PG8_STAGE(PG8_SA(0, 1), cA + hstepA, voffA);
        if (wr == 1) PG8_BAR;
        PG8_WAIT_V(4); PG8_BAR;
        PG8_STAGE(PG8_SB(1, 0), cB + kstep, voffB); PG8_STAGE(PG8_SA(1, 0), cA + kstep, voffA); PG8_STAGE(PG8_SB(1, 1), cB + hstepB + kstep, voffB);
        PG8_WAIT_V(6); PG8_BAR;
    }
    for (;;) {
        const bool has_next = S.next(ui + 1, nxt);
        const char* nA = has_next ? (const char*)g.A + (size_t)nxt.pm * tstepA : cA; const char* nB = has_next ? (const char*)g.Bt + (size_t)nxt.pn * tstepB : cB;
        for (int t = 0; t < nt; t += 2) {
            if constexpr (Epi::MIDHOOK) { if (t == (nt >> 1)) E.mid(acc, cur, wr, wc, fr, fq); }
            const bool last = (t == nt - 2);
            const char* a1 = cA + (size_t)(t + 1) * kstep;
            const char* a2 = last ? nA : cA + (size_t)(t + 2) * kstep; const char* b2 = last ? nB : cB + (size_t)(t + 2) * kstep;
            const char* a3 = a2 + kstep; const char* b3 = b2 + kstep;
            if (last && has_next) S.a_ready(nxt);
            if constexpr (SP2) {
            PG8_LDB(B0, 0, 0); PG8_LDB(B1, 0, 1); PG8_SCHED; PG8_LDA(At, 0, 0); PG8_STAGE(PG8_SA(1, 1), a1 + hstepA, voffA);
            PG8_WAIT_V(8); PG8_WAIT_L(0); PG8_BAR; PG8_MMA(0, 0, At, B0); PG8_MMA(0, 1, At, B1); PG8_BAR; PG8_SCHED;
            PG8_LDA(At, 0, 1); PG8_STAGE(PG8_SB(0, 0), b2, voffB); PG8_STAGE(PG8_SB(0, 1), b2 + hstepB, voffB); PG8_STAGE(PG8_SA(0, 0), a2, voffA);
            PG8_WAIT_V(8); PG8_WAIT_L(0); PG8_BAR; PG8_MMA(1, 0, At, B0); PG8_MMA(1, 1, At, B1); PG8_BAR; PG8_SCHED;
            PG8_LDB(B0, 1, 0); PG8_LDB(B1, 1, 1); PG8_SCHED; PG8_LDA(At, 1, 0); PG8_STAGE(PG8_SA(0, 1), a2 + hstepA, voffA);
            PG8_WAIT_V(8); PG8_WAIT_L(0); PG8_BAR; PG8_MMA(0, 0, At, B0); PG8_MMA(0, 1, At, B1); PG8_BAR; PG8_SCHED;
            PG8_LDA(At, 1, 1); PG8_STAGE(PG8_SB(1, 0), b3, voffB); PG8_STAGE(PG8_SB(1, 1), b3 + hstepB, voffB); PG8_STAGE(PG8_SA(1, 0), a3, voffA);
            PG8_WAIT_V(8); PG8_WAIT_L(0); PG8_BAR; PG8_MMA(1, 0, At, B0); PG8_MMA(1, 1, At, B1); PG8_BAR; PG8_SCHED;
            } else {
            PG8_LDB(B0, 0, 0); PG8_SCHED; PG8_LDA(At, 0, 0); PG8_STAGE(PG8_SA(1, 1), a1 + hstepA, voffA);
            PG8_WAIT_L(8); PG8_BAR; PG8_WAIT_L(0); PG8_MMA(0, 0, At, B0); PG8_BAR; PG8_SCHED;
            PG8_LDB(B1, 0, 1); PG8_STAGE(PG8_SB(0, 0), b2, voffB);
            PG8_BAR; PG8_WAIT_L(0); PG8_MMA(0, 1, At, B1); PG8_BAR;
            PG8_LDA(At, 0, 1); PG8_STAGE(PG8_SA(0, 0), a2, voffA);
            PG8_BAR; PG8_WAIT_L(0); PG8_MMA(1, 0, At, B0); PG8_BAR; PG8_SCHED;
            PG8_STAGE(PG8_SB(0, 1), b2 + hstepB, voffB);
            PG8_WAIT_V(6); PG8_BAR; PG8_MMA(1, 1, At, B1); PG8_BAR;
            PG8_LDB(B0, 1, 0); PG8_SCHED; PG8_LDA(At, 1, 0); PG8_STAGE(PG8_SA(0, 1), a2 + hstepA, voffA);
            PG8_WAIT_L(8); PG8_BAR; PG8_WAIT_L(0); PG8_MMA(0, 0, At, B0); PG8_BAR; PG8_SCHED;
            PG8_LDB(B1, 1, 1); PG8_STAGE(PG8_SB(1, 0), b3, voffB);
            PG8_BAR; PG8_WAIT_L(0); PG8_MMA(0, 1, At, B1); PG8_BAR;
            PG8_LDA(At, 1, 1); PG8_STAGE(PG8_SA(1, 0), a3, voffA);
            PG8_BAR; PG8_WAIT_L(0); PG8_MMA(1, 0, At, B0); PG8_BAR; PG8_SCHED;
            PG8_STAGE(PG8_SB(1, 1), b3 + hstepB, voffB);
            PG8_WAIT_V(6); PG8_BAR; PG8_MMA(1, 1, At, B1); PG8_BAR;
            }
        }
        if constexpr (ALIGN_EPI) { if (wr == 0) PG8_BAR; }
        if constexpr (!Epi::AFTER_DRAIN) { E(acc, cur, wr, wc, fr, fq); S.done(cur); }
        if (!has_next) break;
#pragma unroll
        for (int a = 0; a < 2; ++a)
#pragma unroll
            for (int b = 0; b < 2; ++b)
#pragma unroll
                for (int m = 0; m < 4; ++m)
#pragma unroll
                    for (int n = 0; n < 2; ++n) acc[a][b][m][n] = (f32x4){0.f, 0.f, 0.f, 0.f};
        cur = nxt; cA = nA; cB = nB; ++ui;
        if constexpr (ALIGN_EPI) { if (wr == 1) PG8_BAR; }
    }
    PG8_WAIT_V(0);
    if constexpr (!ALIGN_EPI) { if (wr == 0) PG8_BAR; }
    PG8_BAR;
    if constexpr (Epi::AFTER_DRAIN) { E.fused(acc, cur, wr, wc, fr, fq, lds, wid, lane); S.done(cur); }
#undef PG8_SA
#undef PG8_SB
#undef PG8_STAGE
#undef PG8_LDA
#undef PG8_LDB
#undef PG8_MMA
#undef PG8_WAIT_V
#undef PG8_WAIT_L
#undef PG8_BAR
#undef PG8_SCHED
}
}

namespace fox {
constexpr int D = 128; constexpr float THR = 24.f; constexpr bool WSKIP = false; constexpr int OSTR = 1024, ZSTR = 3072;
constexpr float SCALE = 0.08838834764831845f;
constexpr int NW = 8, QBLK = 32, KVBLK = 64, QB = NW * QBLK;
constexpr int SHM_V = KVBLK * D * 2, SHM_K = KVBLK * D * 2;
constexpr int BIAS_OFF = 2 * SHM_V + 2 * SHM_K + NW * 64 * 4, SLOT_OFF = BIAS_OFF + 512, LDS_BYTES = SLOT_OFF + 64;

using bf16 = __hip_bfloat16;
typedef short bf16x8 __attribute__((ext_vector_type(8)));
typedef short s16x4 __attribute__((ext_vector_type(4)));
typedef float f32x16 __attribute__((ext_vector_type(16)));
typedef float f32x4 __attribute__((ext_vector_type(4)));
typedef unsigned u32x4 __attribute__((ext_vector_type(4)));
template <class A, class Bt> struct same_t { static constexpr bool v = false; };
template <class A> struct same_t<A, A> { static constexpr bool v = true; };

#define KSWZ(row, colB) ((row) * 256 + ((colB) ^ (((row) & 7) << 4)))
#define SBAR() __builtin_amdgcn_sched_barrier(0)
__device__ __forceinline__ int v_st(int k, int c) { const int kk = (k & ~0xC) | ((k & 4) << 1) | ((k & 8) >> 1); return ((kk >> 3) * 4 + (c >> 5)) * 512 + ((kk & 7) * 32 + (c & 31)) * 2; }
__device__ __forceinline__ int v_rd_base(int lane) { return ((lane & 3) << 3) | (((lane >> 2) & 3) << 6) | (((lane >> 4) & 1) << 5) | (((lane >> 5) & 1) << 8); }
constexpr int v_rd_off(int d0, int ks, int half) { return d0 * 512 + ks * 4096 + half * 2048; }
__device__ __forceinline__ int crow(int r, int hi) { return (r & 3) + 8 * (r >> 2) + 4 * hi; }
__device__ __forceinline__ unsigned cvtpk(float lo, float hi) {
    unsigned r; asm volatile("v_cvt_pk_bf16_f32 %0, %1, %2" : "=v"(r) : "v"(lo), "v"(hi)); return r;
}
__device__ __forceinline__ bf16x8 pack8(f32x4 a, f32x4 b) {
    u32x4 w = {cvtpk(a[0], a[1]), cvtpk(a[2], a[3]), cvtpk(b[0], b[1]), cvtpk(b[2], b[3])};
    return *reinterpret_cast<bf16x8*>(&w);
}
template <class T> __device__ __forceinline__ bf16x8 load8(const T* p) {
    if constexpr (same_t<T, float>::v) { return pack8(*(const f32x4*)p, *(const f32x4*)(p + 4)); }
    else { return *reinterpret_cast<const bf16x8*>(p); }
}
__device__ __forceinline__ void mask_tile(f32x16& p0, f32x16& p1, int dq, unsigned W) {
    const float NEG = -__builtin_inff();
#pragma unroll
    for (int r = 0; r < 16; ++r) {
        const int c = (r & 3) + 8 * (r >> 2);
        if ((unsigned)(dq - c) >= W) p0[r] = NEG;
        if ((unsigned)(dq - c - 32) >= W) p1[r] = NEG;
    }
}
__device__ __forceinline__ void partialSM(f32x16& p0, f32x16& p1, float& m_reg, float& mn, float& alpha) {
    float pmax = p0[0]; for (int r = 1; r < 16; ++r) pmax = fmaxf(pmax, p0[r]); for (int r = 0; r < 16; ++r) pmax = fmaxf(pmax, p1[r]);
    { auto rr = __builtin_amdgcn_permlane32_swap(__float_as_uint(pmax), __float_as_uint(pmax), false, false);
      pmax = fmaxf(__uint_as_float(rr[0]), __uint_as_float(rr[1])); }
    constexpr float C2 = 1.4426950408889634f * SCALE;
    if (__builtin_expect(__all((pmax - m_reg) * SCALE <= THR), 1)) { mn = m_reg; alpha = 1.f; }
    else { mn = fmaxf(m_reg, pmax); alpha = __builtin_amdgcn_exp2f((m_reg - mn) * C2); m_reg = mn; }
    const float mnL = -mn * C2;
    for (int r = 0; r < 16; ++r) p0[r] = fmaf(p0[r], C2, mnL); for (int r = 0; r < 16; ++r) p1[r] = fmaf(p1[r], C2, mnL);
    for (int r = 0; r < 16; ++r) p0[r] = __builtin_amdgcn_exp2f(p0[r]);
}
__device__ __forceinline__ void finishSM(f32x16& p0, f32x16& p1, float alpha, float& l_reg, bf16x8& pa0, bf16x8& pa1, bf16x8& pa2, bf16x8& pa3) {
    for (int r = 0; r < 16; ++r) p1[r] = __builtin_amdgcn_exp2f(p1[r]);
    float ps = 0; for (int r = 0; r < 16; ++r) ps += p0[r]; for (int r = 0; r < 16; ++r) ps += p1[r];
    { auto rr = __builtin_amdgcn_permlane32_swap(__float_as_uint(ps), __float_as_uint(ps), false, false);
      ps = __uint_as_float(rr[0]) + __uint_as_float(rr[1]); }
    l_reg = l_reg * alpha + ps;
#define PK4(P, B_, OUT) do { unsigned a0 = cvtpk(P[B_+0], P[B_+1]), a1 = cvtpk(P[B_+2], P[B_+3]);                          \
        unsigned b0 = cvtpk(P[B_+4], P[B_+5]), b1 = cvtpk(P[B_+6], P[B_+7]);                                             \
        auto r0 = __builtin_amdgcn_permlane32_swap(a0, b0, false, false); auto r1 = __builtin_amdgcn_permlane32_swap(a1, b1, false, false); \
        u32x4 w = {r0[0], r1[0], r0[1], r1[1]}; OUT = *reinterpret_cast<bf16x8*>(&w); } while (0)
    PK4(p0, 0, pa0); PK4(p0, 8, pa1); PK4(p1, 0, pa2); PK4(p1, 8, pa3);
#undef PK4
}
template <int KB, bool SK>
__device__ __forceinline__ void qkt(f32x16& p0, f32x16& p1, const char* K_lds, int r32, int hi, const bf16x8* qr, bool act) {
    if (SK && !act) { const float NEG = -__builtin_inff();
#pragma unroll
        for (int r = 0; r < 16; ++r) { p0[r] = NEG; p1[r] = NEG; } return; }
    { const char* bb = K_lds + 2 * SHM_K + NW * 64 * 4 + KB * 256 + hi * 16;
      const f32x4 b0 = *(const f32x4*)(bb), b1 = *(const f32x4*)(bb + 32), b2 = *(const f32x4*)(bb + 64), b3 = *(const f32x4*)(bb + 96);
      const f32x4 c0 = *(const f32x4*)(bb + 128), c1 = *(const f32x4*)(bb + 160), c2 = *(const f32x4*)(bb + 192), c3 = *(const f32x4*)(bb + 224);
      p0 = (f32x16){b0[0], b0[1], b0[2], b0[3], b1[0], b1[1], b1[2], b1[3], b2[0], b2[1], b2[2], b2[3], b3[0], b3[1], b3[2], b3[3]};
      p1 = (f32x16){c0[0], c0[1], c0[2], c0[3], c1[0], c1[1], c1[2], c1[3], c2[0], c2[1], c2[2], c2[3], c3[0], c3[1], c3[2], c3[3]}; }
    const char* kb[4];
#pragma unroll
    for (int dd = 0; dd < 4; ++dd) kb[dd] = K_lds + KB * SHM_K + KSWZ(r32, (dd * 16 + hi * 8) * 2);
#pragma unroll
    for (int d0 = 0; d0 < 8; ++d0) { const char* a = kb[d0 & 3] + (d0 >> 2) * 128;
        bf16x8 b0 = *reinterpret_cast<const bf16x8*>(a);
        bf16x8 b1 = *reinterpret_cast<const bf16x8*>(a + 32 * 256);
        p0 = __builtin_amdgcn_mfma_f32_32x32x16_bf16(b0, qr[d0], p0, 0, 0, 0);
        p1 = __builtin_amdgcn_mfma_f32_32x32x16_bf16(b1, qr[d0], p1, 0, 0, 0); }
}
template <int VB, bool SK>
__device__ __forceinline__ void pv_tile(f32x16* o, int vb0, bf16x8 pa0, bf16x8 pa1, bf16x8 pa2, bf16x8 pa3, bool act) {
    if (SK && !act) return;
#define TRRD(dst, off) asm volatile("ds_read_b64_tr_b16 %0, %1 offset:%2" : "=&v"(dst) : "v"(vb0), "i"(off) : "memory")
#define PV_D0(d0) do { s16x4 l0, l1, l2, l3, h0, h1, h2, h3; constexpr int b_ = VB * SHM_V + v_rd_off(d0, 0, 0);     \
        TRRD(l0, b_); TRRD(h0, b_ + 2048); TRRD(l1, b_ + 4096); TRRD(h1, b_ + 6144); TRRD(l2, b_ + 8192); TRRD(h2, b_ + 10240); TRRD(l3, b_ + 12288); TRRD(h3, b_ + 14336); \
        asm volatile("s_waitcnt lgkmcnt(0)" ::: "memory"); SBAR();                 \
        o[d0] = __builtin_amdgcn_mfma_f32_32x32x16_bf16(pa0, (bf16x8){l0[0], l0[1], l0[2], l0[3], h0[0], h0[1], h0[2], h0[3]}, o[d0], 0, 0, 0);   \
        o[d0] = __builtin_amdgcn_mfma_f32_32x32x16_bf16(pa1, (bf16x8){l1[0], l1[1], l1[2], l1[3], h1[0], h1[1], h1[2], h1[3]}, o[d0], 0, 0, 0);   \
        o[d0] = __builtin_amdgcn_mfma_f32_32x32x16_bf16(pa2, (bf16x8){l2[0], l2[1], l2[2], l2[3], h2[0], h2[1], h2[2], h2[3]}, o[d0], 0, 0, 0);   \
        o[d0] = __builtin_amdgcn_mfma_f32_32x32x16_bf16(pa3, (bf16x8){l3[0], l3[1], l3[2], l3[3], h3[0], h3[1], h3[2], h3[3]}, o[d0], 0, 0, 0); } while (0)
    PV_D0(0); PV_D0(1); PV_D0(2); PV_D0(3);
#undef PV_D0
#undef TRRD
}

template <class TIn, class TOut> struct BlockRef { const TIn* Q; const TIn* K; const TIn* V; TOut* O; const float* KB; const unsigned short* Z; int P0; int JLO; };
template <class TIn> struct Seam {
    bf16x8 qr[8];
    bf16x8 st_v0, st_v1, st_k0, st_k1; float st_b; f32x4 sf0, sf1, sf2, sf3;
    f32x4 tq[16];
};
__device__ __forceinline__ int swa_jlo(int P0, int W) { const int lowk = P0 - W + 1; return lowk > 0 ? lowk / KVBLK : 0; }
#define ROW(p, k0, rr) ((p) + (size_t)((k0) + (rr)) * D + sc)
#define VMW() asm volatile("s_waitcnt vmcnt(0)" ::: "memory")
#define VMWN(n) asm volatile("s_waitcnt vmcnt(%0)" :: "i"(n) : "memory")
#define SLOAD_H(Kp, Vp, Bp, k0) do { S.st_v0 = load8<TIn>(ROW(Vp, k0, sr)); S.st_v1 = load8<TIn>(ROW(Vp, k0, 32 + sr)); S.st_b = (Bp)[(k0) + (r32 | (hi << 5))]; \
                         S.st_k0 = load8<TIn>(ROW(Kp, k0, sr)); S.st_k1 = load8<TIn>(ROW(Kp, k0, 32 + sr)); } while (0)
#define SWRITE_HK(bf) do { *(bf16x8*)(K_lds + (bf) * SHM_K + kws) = S.st_k0; *(bf16x8*)(K_lds + (bf) * SHM_K + kws + 32 * 256) = S.st_k1; if (wid == 0) *(float*)(K_lds + 2 * SHM_K + NW * 64 * 4 + (bf) * 256 + (r32 | (hi << 5)) * 4) = S.st_b; } while (0)
#define SWRITE_HV(bf) do { *(bf16x8*)(V_lds + (bf) * SHM_V + vst0) = S.st_v0; *(bf16x8*)(V_lds + (bf) * SHM_V + vst1) = S.st_v1; } while (0)
#define SWRITE_H(bf) do { SWRITE_HV(bf); SWRITE_HK(bf); } while (0)
#define SLOAD_F(p, k0) do { S.sf0 = *(const f32x4*)ROW(p, k0, sr); S.sf1 = *(const f32x4*)(ROW(p, k0, sr) + 4);                \
                            S.sf2 = *(const f32x4*)ROW(p, k0, 32 + sr); S.sf3 = *(const f32x4*)(ROW(p, k0, 32 + sr) + 4); } while (0)
#define SWRITE_KF(bf) do { *(bf16x8*)(K_lds + (bf) * SHM_K + kws) = pack8(S.sf0, S.sf1); *(bf16x8*)(K_lds + (bf) * SHM_K + kws + 32 * 256) = pack8(S.sf2, S.sf3); } while (0)
#define SWRITE_VF(bf) do { *(bf16x8*)(V_lds + (bf) * SHM_V + vst0) = pack8(S.sf0, S.sf1); *(bf16x8*)(V_lds + (bf) * SHM_V + vst1) = pack8(S.sf2, S.sf3); } while (0)
template <class TIn, class TOut>
__device__ __forceinline__ void causal_swa_prime(const BlockRef<TIn, TOut>& cur, int W, char* lds, Seam<TIn>& S) {
    constexpr bool F32 = same_t<TIn, float>::v;
    const int tid = threadIdx.x, wid = __builtin_amdgcn_readfirstlane(tid >> 6), lane = tid & 63, r32 = lane & 31, hi = lane >> 5;
    const int sr = tid >> 4, sc = (tid & 15) * 8, kws = KSWZ(sr, sc * 2); char* K_lds = lds + 2 * SHM_V;
    const int kb0 = cur.JLO * KVBLK;
    for (int d0 = 0; d0 < 8; ++d0) S.qr[d0] = load8<TIn>(cur.Q + (size_t)(wid * QBLK + r32) * D + d0 * 16 + hi * 8);
    if constexpr (F32) { SLOAD_F((const float*)cur.K, kb0); VMW(); SWRITE_KF(0); SBAR(); SLOAD_F((const float*)cur.V, kb0); }
    else { SLOAD_H(cur.K, cur.V, cur.KB, kb0); VMW(); SWRITE_HK(0); }
    __syncthreads();
}
template <class TIn, class TOut>
__device__ __forceinline__ void causal_swa_block(const BlockRef<TIn, TOut>& cur, const BlockRef<TIn, TOut>& nxt, int skv, int W, char* lds, Seam<TIn>& S) {
    constexpr bool F32 = same_t<TIn, float>::v;
    const int tid = threadIdx.x, wid = __builtin_amdgcn_readfirstlane(tid >> 6), lane = tid & 63, r32 = lane & 31, hi = lane >> 5;
    const int j_lo = cur.JLO;
    int j_hi = (cur.P0 + QB - 1) / KVBLK + 1; if (j_hi > skv / KVBLK) j_hi = skv / KVBLK;
    const int NT = j_hi - j_lo;
    const int kbn = nxt.JLO * KVBLK;
    const int qlo = cur.P0 + wid * QBLK, qm = qlo + r32 - 4 * hi;
    char* V_lds = lds; char* K_lds = lds + 2 * SHM_V;
    float* ws = (float*)(lds + 2 * SHM_V + 2 * SHM_K) + wid * 64; float* li_l = ws, * al_l = ws + 32;
    float m_reg = -1e30f, l_reg = 0; f32x16 o[4] = {};
    const int sr = tid >> 4, sc = (tid & 15) * 8, vst0 = v_st(sr, sc), vst1 = v_st(32 + sr, sc), kws = KSWZ(sr, sc * 2);
    const int vb0 = (int)(uintptr_t)V_lds + v_rd_base(lane);
    const TIn* Kh = cur.K; const TIn* Vh = cur.V; const float* Bh = cur.KB;
#define RESC(a) do { if (__any((a) < 1.f)) { if (hi == 0) al_l[r32] = (a); asm volatile("s_waitcnt lgkmcnt(0)" ::: "memory");              \
                     for (int d_ = 0; d_ < 4; ++d_) for (int r = 0; r < 16; ++r) o[d_][r] *= al_l[crow(r, hi)]; } } while (0)
#define KBASE(t) ((j_lo + (t)) * KVBLK)
#define ACT(t) (KBASE(t) <= qlo + QBLK - 1 && KBASE(t) + KVBLK - 1 >= qlo - W + 1)
#define MASKT(P0_, P1_, t) do { const int kb_ = KBASE(t); if ((!SK || ACT(t)) && (kb_ + KVBLK - 1 > qlo || kb_ <= qlo + QBLK - 1 - W)) mask_tile(P0_, P1_, qm - kb_, (unsigned)W); } while (0)
    constexpr int NQL = F32 ? 16 : 8;
    constexpr bool SK = WSKIP && !F32;
#define SEAM_K0() do { VMWN(NQL); if constexpr (F32) { SWRITE_KF(0); SBAR(); SLOAD_F((const float*)nxt.V, kbn); } else { SWRITE_HK(0); } SBAR(); } while (0)
    f32x16 pA0, pA1, pB0, pB1; float mnA, mnB, alA, alB; bf16x8 pa0, pa1, pa2, pa3;
    if constexpr (F32) { VMW(); SWRITE_VF(0); SBAR(); } else { SWRITE_HV(0); SBAR(); }
    if (NT > 1) { if constexpr (F32) SLOAD_F((const float*)Kh, KBASE(1)); else SLOAD_H(Kh, Vh, Bh, KBASE(1)); }
    SBAR(); qkt<0, SK>(pA0, pA1, K_lds, r32, hi, S.qr, ACT(0));
    if constexpr (F32) { if (NT > 1) { VMW(); SWRITE_KF(1); SBAR(); SLOAD_F((const float*)Vh, KBASE(1)); } }
    MASKT(pA0, pA1, 0); partialSM(pA0, pA1, m_reg, mnA, alA);
    if (NT > 1) { VMW(); if constexpr (F32) { SWRITE_VF(1); SBAR(); if (NT > 2) SLOAD_F((const float*)Kh, KBASE(2)); } else SWRITE_H(1); }
    __syncthreads();
#define HALF_STEP(PX0, PX1, mnX, alX, PY0, PY1, alY, t, KB, VB, SB) do {                                                      \
        SBAR(); qkt<KB, SK>(PX0, PX1, K_lds, r32, hi, S.qr, ACT(t));                                             \
        finishSM(PY0, PY1, alY, l_reg, pa0, pa1, pa2, pa3); SBAR();                                                           \
        if ((t) + 1 < NT) { if constexpr (F32) { VMW(); SWRITE_KF(SB); SBAR(); SLOAD_F((const float*)Vh, KBASE((t) + 1)); }  \
                            else { SLOAD_H(Kh, Vh, Bh, KBASE((t) + 1)); } SBAR(); }                                               \
        pv_tile<VB, SK>(o, vb0, pa0, pa1, pa2, pa3, ACT((t) - 1)); MASKT(PX0, PX1, (t)); partialSM(PX0, PX1, m_reg, mnX, alX);                                        \
        __syncthreads();                                                                                                      \
        if ((t) + 1 < NT) { VMW(); if constexpr (F32) { SWRITE_VF(SB); SBAR(); if ((t) + 2 < NT) SLOAD_F((const float*)Kh, KBASE((t) + 2)); } \
                            else { SWRITE_H(SB); } }                                                                          \
        RESC(alX); __syncthreads(); } while (0)
    for (int t = 1; t + 1 < NT; t += 2) {
        HALF_STEP(pB0, pB1, mnB, alB, pA0, pA1, alA, t, 1, 0, 0);
        HALF_STEP(pA0, pA1, mnA, alA, pB0, pB1, alB, t + 1, 0, 1, 1);
    }
    const bool even = (NT & 1) == 0;
    if (even) { SBAR(); qkt<1, SK>(pB0, pB1, K_lds, r32, hi, S.qr, ACT(NT - 1)); SBAR(); }
#define QROW(e) (nxt.Q + (size_t)(wid * QBLK + r32) * D + ((e) >> 1) * 16 + hi * 8 + ((e) & 1) * 4)
    if constexpr (F32) { SLOAD_F((const float*)nxt.K, kbn); SBAR();
#pragma unroll
        for (int e = 0; e < 8; ++e) S.tq[e] = *(const f32x4*)QROW(e); }
    else { SLOAD_H(nxt.K, nxt.V, nxt.KB, kbn); SBAR();
#pragma unroll
        for (int d0 = 0; d0 < 8; ++d0) S.qr[d0] = load8<TIn>(nxt.Q + (size_t)(wid * QBLK + r32) * D + d0 * 16 + hi * 8); }
    SBAR();
    finishSM(pA0, pA1, alA, l_reg, pa0, pa1, pa2, pa3); SBAR();
    if constexpr (F32) {
#pragma unroll
        for (int e = 8; e < 16; ++e) S.tq[e] = *(const f32x4*)QROW(e); SBAR(); }
#undef QROW
    pv_tile<0, SK>(o, vb0, pa0, pa1, pa2, pa3, ACT(even ? NT - 2 : NT - 1));
    if (even) { MASKT(pB0, pB1, NT - 1); partialSM(pB0, pB1, m_reg, mnB, alB); __syncthreads(); RESC(alB);
        finishSM(pB0, pB1, alB, l_reg, pa0, pa1, pa2, pa3); SBAR(); pv_tile<1, SK>(o, vb0, pa0, pa1, pa2, pa3, ACT(NT - 1)); }
    SBAR(); SEAM_K0();
    if (hi == 0) li_l[r32] = l_reg; asm volatile("s_waitcnt lgkmcnt(0)" ::: "memory");
    float rli[16];
#pragma unroll
    for (int r = 0; r < 16; ++r) rli[r] = __builtin_amdgcn_rcpf(li_l[crow(r, hi)]);
    TOut* Ow = cur.O + (size_t)((wid * QBLK + 4 * hi) * OSTR + r32); const unsigned short* Zw = cur.Z + (size_t)((wid * QBLK + 4 * hi) * ZSTR + r32);
#pragma unroll
    for (int r = 0; r < 16; ++r) { const int orow = (r & 3) + 8 * (r >> 2);
#pragma unroll
        for (int d0 = 0; d0 < 4; ++d0) { const float zg = __uint_as_float((unsigned)Zw[orow * ZSTR + d0 * 32] << 16);
            const float v = o[d0][r] * rli[r] * zg * __builtin_amdgcn_rcpf(1.f + __builtin_amdgcn_exp2f(-1.4426950408889634f * zg));
            if constexpr (same_t<TOut, float>::v) { Ow[orow * OSTR + d0 * 32] = v; }
            else { const float vn = __shfl_xor(v, 1);
                   if ((r32 & 1) == 0) *(unsigned*)(Ow + orow * OSTR + d0 * 32) = cvtpk(v, vn); } }
        if (r & 1) asm volatile("" ::: "memory"); }
    if constexpr (F32) {
#pragma unroll
        for (int d0 = 0; d0 < 8; ++d0) S.qr[d0] = pack8(S.tq[2 * d0], S.tq[2 * d0 + 1]); }
    __syncthreads();
#undef RESC
#undef KBASE
#undef ACT
#undef MASKT
#undef SEAM_K0
#undef HALF_STEP
}
#undef ROW
#undef VMW
#undef VMWN
#undef SLOAD_H
#undef SWRITE_HK
#undef SWRITE_HV
#undef SWRITE_H
#undef SLOAD_F
#undef SWRITE_KF
#undef SWRITE_VF

}
constexpr int LDS_TOTAL = 159744;
constexpr int GEMM_X_OFF = 131072;

__device__ __forceinline__ int phys2log(int n) {
    if (n < 1536) return n;
    if (n < 2048) return n + 8;
    if (n < 3584) return n + 8;
    if (n < 4096) return n + 12;
    return n + 12;
}

__device__ void phase_prologue(const Params& p, unsigned char* lds) {
    const int tid = threadIdx.x, lane = tid & 63, w = tid >> 6;
    float* L = (float*)lds;
    if (blockIdx.x == 0 && tid < 16) { ((unsigned*)(p.ws + WS_CTRL))[tid] = 0u; }
    if (blockIdx.x < 48) {
        const int j = blockIdx.x * 64 + lane;
        float acc[8] = {0.f, 0.f, 0.f, 0.f, 0.f, 0.f, 0.f, 0.f};
        for (int k = w * 128; k < w * 128 + 128; ++k) { const float wv = p.w_ada[(size_t)k * 3072 + j];
#pragma unroll
            for (int b = 0; b < 8; ++b) acc[b] += p.c[b * 1024 + k] * wv; }
#pragma unroll
        for (int b = 0; b < 8; ++b) L[(w * 8 + b) * 64 + lane] = acc[b];
        __syncthreads();
        { const int b = w; float s = p.b_ada[j];
#pragma unroll
          for (int ww = 0; ww < 8; ++ww) s += L[(ww * 8 + b) * 64 + lane];
          ((float*)(p.ws + WS_MOD))[b * 3072 + j] = s; }
        __syncthreads();
    }
    { const int gt = blockIdx.x * 512 + tid;
      if (gt < 12288) { const int j = gt >> 10, k = gt & 1023; const int col = j < 8 ? 1536 + j : 3592 + (j - 8);
          ((float*)(p.ws + WS_WSMALL))[gt] = p.w_in[(size_t)k * DIN + col]; } }
    unsigned short* WIN_T = (unsigned short*)(p.ws + WS_WIN_T); unsigned short* WO2_T = (unsigned short*)(p.ws + WS_WO2_T); unsigned short* WOUT2_T = (unsigned short*)(p.ws + WS_WOUT2_T);
    for (int tile = blockIdx.x; tile < 2048; tile += gridDim.x) {
        const float* src; int sld; unsigned short* dst; int dld; unsigned short* dst2 = nullptr;
        if (tile < 1536) { const int kt = tile / 96, nt = tile % 96; src = p.w_in + (size_t)(kt * 64) * DIN + phys2log(nt * 64); sld = DIN; dst = WIN_T + (size_t)(nt * 64) * 1024 + kt * 64; dld = 1024; }
        else if (tile < 1792) { const int idx = tile - 1536, nt = idx & 31, kt = idx >> 5; src = (nt < 16 ? p.w_o_gdn : p.w_o_fox) + (size_t)(kt * 64) * 1024 + (nt & 15) * 64; sld = 1024; dst = WO2_T + (size_t)((nt & 15) * 64) * 1024 + (nt < 16 ? 0 : 512) + kt * 64; dld = 1024; }
        else { const int idx = tile - 1792, nt = idx & 15, kt = idx >> 4; src = p.w_out + (size_t)(kt * 64) * 1024 + nt * 64; sld = 1024; dst = WOUT2_T + (size_t)(nt * 64) * 2048 + kt * 64; dld = 2048; dst2 = dst + 1024; }
        { const int i = tid >> 3, js = (tid & 7) * 8;
          const float4 a = *(const float4*)(src + (size_t)i * sld + js), b = *(const float4*)(src + (size_t)i * sld + js + 4);
          float* r = L + i * 65 + js; r[0] = a.x; r[1] = a.y; r[2] = a.z; r[3] = a.w; r[4] = b.x; r[5] = b.y; r[6] = b.z; r[7] = b.w; }
        __syncthreads();
        { const int n = tid >> 3, ks = (tid & 7) * 8; float v[8];
#pragma unroll
          for (int q = 0; q < 8; ++q) v[q] = L[(ks + q) * 65 + n];
          uint4 o; o.x = pk_bf16(v[0], v[1]); o.y = pk_bf16(v[2], v[3]); o.z = pk_bf16(v[4], v[5]); o.w = pk_bf16(v[6], v[7]);
          *(uint4*)(dst + (size_t)n * dld + ks) = o; if (dst2) *(uint4*)(dst2 + (size_t)n * dld + ks) = o; }
        __syncthreads();
    }
}

__device__ void phase_prepass(const Params& p, unsigned char* lds) {
    const int tid = threadIdx.x, lane = tid & 63, w = tid >> 6, l5 = lane & 31, up = lane >> 5;
    float* Wsm = (float*)lds;
    { const float* src = (const float*)(p.ws + WS_WSMALL); for (int i = tid; i < 12288; i += 512) Wsm[i] = src[i]; }
    __syncthreads();
    const float* mod = (const float*)(p.ws + WS_MOD);
    unsigned short* HB = (unsigned short*)(p.ws + WS_HB);
    float* GDEC = (float*)(p.ws + WS_GDEC); float* BETA = (float*)(p.ws + WS_BETA); float* LOGF = (float*)(p.ws + WS_LOGF);
    const int nwave = gridDim.x * 8, rows_per = MTOK / nwave;
    const int gw = blockIdx.x * 8 + w;
    const float gA = l5 < 4 ? -__expf(p.A_log[l5 & 3]) : 0.f;
    const float gbias = l5 < 4 ? p.dt_bias[l5 & 3] : (l5 >= 8 && l5 < 12 ? p.b_f[l5 & 3] : 0.f);
    float* gdst = (l5 < 4 ? GDEC : (l5 < 8 ? BETA : LOGF)) + (l5 & 3);
    for (int r0 = gw * rows_per; r0 < (gw + 1) * rows_per; r0 += 32) {
        const int b = r0 >> 13;
        float4 gs[4], sh[4];
#pragma unroll
        for (int i = 0; i < 4; ++i) { const int e = i * 256 + lane * 4; const float4 g = *(const float4*)(p.g_norm + e), sc = *(const float4*)(mod + b * 3072 + 1024 + e); sh[i] = *(const float4*)(mod + b * 3072 + e);
            gs[i].x = g.x * (1.f + sc.x); gs[i].y = g.y * (1.f + sc.y); gs[i].z = g.z * (1.f + sc.z); gs[i].w = g.w * (1.f + sc.w); }
        const int rend = (r0 + 32 < (gw + 1) * rows_per) ? r0 + 32 : (gw + 1) * rows_per;
        float4 xn0[4], xn1[4];
        { const int rb = (r0 + 1 < rend) ? r0 + 1 : r0;
#pragma unroll
          for (int i = 0; i < 4; ++i) { xn0[i] = *(const float4*)(p.x + (size_t)r0 * DM + i * 256 + lane * 4); xn1[i] = *(const float4*)(p.x + (size_t)rb * DM + i * 256 + lane * 4); } }
#pragma unroll 1
        for (int r = r0; r < rend; r += 2) {
            const bool hasb = r + 1 < rend;
            float4 xa[4], xb[4]; float ssa = 0.f, ssb = 0.f;
#pragma unroll
            for (int i = 0; i < 4; ++i) { xa[i] = xn0[i]; xb[i] = xn1[i];
                ssa += xa[i].x * xa[i].x + xa[i].y * xa[i].y + xa[i].z * xa[i].z + xa[i].w * xa[i].w; ssb += xb[i].x * xb[i].x + xb[i].y * xb[i].y + xb[i].z * xb[i].z + xb[i].w * xb[i].w; }
            { const int ra = (r + 2 < rend) ? r + 2 : r, rb = (r + 3 < rend) ? r + 3 : ra;
#pragma unroll
              for (int i = 0; i < 4; ++i) { xn0[i] = *(const float4*)(p.x + (size_t)ra * DM + i * 256 + lane * 4); xn1[i] = *(const float4*)(p.x + (size_t)rb * DM + i * 256 + lane * 4); } }
            float rstd_a, rstd_b;
            { float v = up ? ssb : ssa; const float snd = up ? ssa : ssb; v += __shfl_xor(snd, 32);
#pragma unroll
              for (int o = 16; o >= 1; o >>= 1) v += __shfl_xor(v, o);
              const float ta = __shfl(v, 0), tb = __shfl(v, 32);
              rstd_a = __builtin_amdgcn_rsqf(ta * (1.0f / 1024.0f) + 1e-6f); rstd_b = __builtin_amdgcn_rsqf(tb * (1.0f / 1024.0f) + 1e-6f); }
#pragma unroll
            for (int i = 0; i < 4; ++i) {
                xa[i].x = xa[i].x * rstd_a * gs[i].x + sh[i].x; xa[i].y = xa[i].y * rstd_a * gs[i].y + sh[i].y; xa[i].z = xa[i].z * rstd_a * gs[i].z + sh[i].z; xa[i].w = xa[i].w * rstd_a * gs[i].w + sh[i].w;
                xb[i].x = xb[i].x * rstd_b * gs[i].x + sh[i].x; xb[i].y = xb[i].y * rstd_b * gs[i].y + sh[i].y; xb[i].z = xb[i].z * rstd_b * gs[i].z + sh[i].z; xb[i].w = xb[i].w * rstd_b * gs[i].w + sh[i].w;
                uint2 o; o.x = pk_bf16(xa[i].x, xa[i].y); o.y = pk_bf16(xa[i].z, xa[i].w); *(uint2*)(HB + (size_t)r * DM + i * 256 + lane * 4) = o;
                if (hasb) { uint2 o2; o2.x = pk_bf16(xb[i].x, xb[i].y); o2.y = pk_bf16(xb[i].z, xb[i].w); *(uint2*)(HB + (size_t)(r + 1) * DM + i * 256 + lane * 4) = o2; } }
            float mine = 0.f;
#pragma unroll
            for (int j = 0; j < 12; ++j) { float da = 0.f, db = 0.f;
#pragma unroll
                for (int i = 0; i < 4; ++i) { const float4 wv = *(const float4*)(Wsm + j * 1024 + i * 256 + lane * 4);
                    da += xa[i].x * wv.x + xa[i].y * wv.y + xa[i].z * wv.z + xa[i].w * wv.w; db += xb[i].x * wv.x + xb[i].y * wv.y + xb[i].z * wv.z + xb[i].w * wv.w; }
                float v = up ? db : da; const float snd = up ? da : db; v += __shfl_xor(snd, 32);
#pragma unroll
                for (int o = 16; o >= 1; o >>= 1) v += __shfl_xor(v, o);
                if (l5 == j) mine = v; }
            if (l5 < 12 && (up == 0 || hasb)) {
                const float t = mine + gbias, u = l5 < 4 ? t : -t;
                const float sp = fmaxf(u, 0.f) + __logf(1.f + __expf(-fabsf(u)));
                gdst[(size_t)(r + up) * 4] = l5 < 4 ? gA * sp : (l5 < 8 ? __expf(-sp) : -sp); }
        }
    }
    __syncthreads();
}

__device__ void phase_cumsum(const Params& p, unsigned char* lds) {
    if (blockIdx.x >= 32) return;
    const int tid = threadIdx.x, lane = tid & 63, w = tid >> 6, bh = blockIdx.x, b = bh >> 2, h = bh & 3;
    float* L = (float*)lds;
    const float* LOGF = (const float*)(p.ws + WS_LOGF); float* KB = (float*)(p.ws + WS_KBIAS) + (size_t)bh * SEQ;
    float v[16]; float s = 0.f;
#pragma unroll
    for (int i = 0; i < 16; ++i) { s += LOGF[((size_t)b * SEQ + tid * 16 + i) * 4 + h]; v[i] = s; }
    float incl = s;
#pragma unroll
    for (int o = 1; o < 64; o <<= 1) { const float t = __shfl_up(incl, o); if (lane >= o) incl += t; }
    if (lane == 63) L[w] = incl;
    __syncthreads();
    float pre = incl - s;
    for (int ww = 0; ww < w; ++ww) pre += L[ww];
#pragma unroll
    for (int i = 0; i < 16; ++i) KB[tid * 16 + i] = -(pre + v[i]) * 11.313708498984761f;
    float* kbEnd = L + 16; float* kbStart = L + 16 + 128; float* gm = L + 16 + 128 + 32;
    if ((tid & 3) == 3) kbEnd[tid >> 2] = -(pre + v[15]) * 11.313708498984761f;
    if ((tid & 15) == 0) kbStart[tid >> 4] = -(pre + v[0]) * 11.313708498984761f;
    if (tid < 128) { gm[tid] = fabsf(p.g_q_fox[tid]); gm[128 + tid] = fabsf(p.g_k_fox[tid]); }
    __syncthreads();
    if (tid < 32) { float gq = 0.f, gk = 0.f;
        for (int i = 0; i < 128; ++i) { gq = fmaxf(gq, gm[i]); gk = fmaxf(gk, gm[128 + i]); }
        const float M = 11.5f * gq * gk, thrK = 11.313708498984761f * (111.0f + 2.0f * M);
        const int qb = tid; const float ks = kbStart[qb]; int j = 0;
        while (j < 4 * qb && ks - kbEnd[j] > thrK) ++j;
        ((int*)(p.ws + WS_JLO))[bh * 32 + qb] = j; }
    __syncthreads();
}

typedef float f32x2 __attribute__((ext_vector_type(2)));
__device__ void gdn_stage_chunk(const Params& p, float* Q, float* K, float* V, float* GA, float* GB, int b, int h, int t0) {
    const int tid = threadIdx.x; const int s = tid >> 3, dg = tid & 7;
    const unsigned short* GQKV = (const unsigned short*)(p.ws + WS_GQKV);
#pragma unroll 1
    for (int part = 0; part < 3; ++part) {
        const int ch0 = part * 512 + h * 128 + dg * 16;
        float a[16];
#pragma unroll
        for (int c = 0; c < 16; ++c) a[c] = 0.f;
#pragma unroll
        for (int i = 0; i < 4; ++i) { const int tt = t0 + s - 3 + i;
            if (tt >= 0) { const uint4 u0 = *(const uint4*)(GQKV + ((size_t)b * SEQ + tt) * 1536 + ch0), u1 = *(const uint4*)(GQKV + ((size_t)b * SEQ + tt) * 1536 + ch0 + 8);
                const unsigned uu[8] = {u0.x, u0.y, u0.z, u0.w, u1.x, u1.y, u1.z, u1.w};
                const float* wp = p.conv_w + i * 1536 + ch0;
#pragma unroll
                for (int q = 0; q < 8; ++q) { a[2 * q] += wp[2 * q] * __uint_as_float(uu[q] << 16); a[2 * q + 1] += wp[2 * q + 1] * __uint_as_float(uu[q] & 0xffff0000u); } } }
        float ss = 0.f;
#pragma unroll
        for (int c = 0; c < 16; ++c) { a[c] = siluf_(a[c]); ss += a[c] * a[c]; }
        float* dst = V;
        if (part < 2) { ss += __shfl_xor(ss, 1); ss += __shfl_xor(ss, 2); ss += __shfl_xor(ss, 4);
            float r = 1.0f / sqrtf(ss + 1e-6f); if (part == 0) r *= 0.08838834764831845f;
#pragma unroll
            for (int c = 0; c < 16; ++c) a[c] *= r;
            dst = part == 0 ? Q : K; }
#pragma unroll
        for (int c = 0; c < 16; c += 4) *(float4*)(dst + s * 128 + dg * 16 + c) = make_float4(a[c], a[c + 1], a[c + 2], a[c + 3]);
    }
    if (tid < 64) { GA[tid] = __expf(((const float*)(p.ws + WS_GDEC))[((size_t)b * SEQ + t0 + tid) * 4 + h]); GB[tid] = ((const float*)(p.ws + WS_BETA))[((size_t)b * SEQ + t0 + tid) * 4 + h]; }
}
__device__ void gdn_epilogue_chunk(const Params& p, const float* O, int b, int h, int t0) {
    const int tid = threadIdx.x; const int s = tid >> 3, dg = tid & 7;
    float o[16]; float ss = 0.f;
#pragma unroll
    for (int c = 0; c < 16; c += 4) { const float4 v = *(const float4*)(O + s * 128 + dg * 16 + c); o[c] = v.x; o[c + 1] = v.y; o[c + 2] = v.z; o[c + 3] = v.w; }
#pragma unroll
    for (int c = 0; c < 16; ++c) ss += o[c] * o[c];
    ss += __shfl_xor(ss, 1); ss += __shfl_xor(ss, 2); ss += __shfl_xor(ss, 4);
    const float rstd = 1.0f / sqrtf(ss * (1.0f / 128.0f) + 1e-6f);
    const size_t tok = (size_t)b * SEQ + t0 + s;
    const unsigned short* zp = (const unsigned short*)(p.ws + WS_ZG) + tok * 3072 + h * 128 + dg * 16;
    const uint4 z0 = *(const uint4*)zp, z1 = *(const uint4*)(zp + 8);
    const unsigned zz[8] = {z0.x, z0.y, z0.z, z0.w, z1.x, z1.y, z1.z, z1.w};
    unsigned ow[8];
#pragma unroll
    for (int q = 0; q < 8; ++q) { const float za = __uint_as_float(zz[q] << 16), zb = __uint_as_float(zz[q] & 0xffff0000u);
        const float va = o[2 * q] * rstd * p.g_gdn_out[dg * 16 + 2 * q] * siluf_(za), vb = o[2 * q + 1] * rstd * p.g_gdn_out[dg * 16 + 2 * q + 1] * siluf_(zb);
        ow[q] = pk_bf16(va, vb); }
    unsigned short* dst = (unsigned short*)(p.ws + WS_HB) + tok * 1024 + h * 128 + dg * 16;
    *(uint4*)dst = make_uint4(ow[0], ow[1], ow[2], ow[3]); *(uint4*)(dst + 8) = make_uint4(ow[4], ow[5], ow[6], ow[7]);
}
__device__ __forceinline__ void gdn_epilogue_chunk_z(const Params& p, const float* O, int b, int h, int t0, uint4 z0, uint4 z1) {
    const int tid = threadIdx.x; const int s = tid >> 3, dg = tid & 7;
    float o[16]; float ss = 0.f;
#pragma unroll
    for (int c = 0; c < 16; c += 4) { const float4 v = *(const float4*)(O + s * 128 + dg * 16 + c); o[c] = v.x; o[c + 1] = v.y; o[c + 2] = v.z; o[c + 3] = v.w; }
#pragma unroll
    for (int c = 0; c < 16; ++c) ss += o[c] * o[c];
    ss += __shfl_xor(ss, 1); ss += __shfl_xor(ss, 2); ss += __shfl_xor(ss, 4);
    const float rstd = 1.0f / sqrtf(ss * (1.0f / 128.0f) + 1e-6f);
    const size_t tok = (size_t)b * SEQ + t0 + s;
    const unsigned zz[8] = {z0.x, z0.y, z0.z, z0.w, z1.x, z1.y, z1.z, z1.w};
    unsigned ow[8];
#pragma unroll
    for (int q = 0; q < 8; ++q) { const float za = __uint_as_float(zz[q] << 16), zb = __uint_as_float(zz[q] & 0xffff0000u);
        const float va = o[2 * q] * rstd * p.g_gdn_out[dg * 16 + 2 * q] * siluf_(za), vb = o[2 * q + 1] * rstd * p.g_gdn_out[dg * 16 + 2 * q + 1] * siluf_(zb);
        ow[q] = pk_bf16(va, vb); }
    unsigned short* dst = (unsigned short*)(p.ws + WS_HB) + tok * 1024 + h * 128 + dg * 16;
    *(uint4*)dst = make_uint4(ow[0], ow[1], ow[2], ow[3]); *(uint4*)(dst + 8) = make_uint4(ow[4], ow[5], ow[6], ow[7]);
}
__device__ void gdn_seq_unit(const Params& p, unsigned char* lds, int bh) {
    float* Q = (float*)lds; float* K = Q + 8192; float* V = K + 8192; float* O = V + 8192; float* GA = O + 8192; float* GB = GA + 64;
    const int tid = threadIdx.x, b = bh >> 2, h = bh & 3;
    f32x2 st[64];
#pragma unroll
    for (int i = 0; i < 64; ++i) st[i] = (f32x2){0.f, 0.f};
    for (int ch = 0; ch < SEQ / 64; ++ch) {
        const int t0 = ch * 64;
        __syncthreads();
        gdn_stage_chunk(p, Q, K, V, GA, GB, b, h, t0);
        __syncthreads();
        if (tid < 128) {
#pragma unroll 1
            for (int s = 0; s < 64; ++s) {
                const float a = GA[s], be = GB[s], v = V[s * 128 + tid];
                f32x2 ks0 = {0.f, 0.f}, ks1 = {0.f, 0.f};
#pragma unroll
                for (int i = 0; i < 64; i += 2) { const float4 kv = *(const float4*)(K + s * 128 + 2 * i); ks0 += (f32x2){kv.x, kv.y} * st[i]; ks1 += (f32x2){kv.z, kv.w} * st[i + 1]; if ((i & 14) == 14) asm volatile("" ::: "memory"); }
                const float kS = a * ((ks0.x + ks0.y) + (ks1.x + ks1.y));
                const float dl = be * (v - kS);
                f32x2 os0 = {0.f, 0.f}, os1 = {0.f, 0.f};
#pragma unroll
                for (int i = 0; i < 64; i += 2) { const float4 kv = *(const float4*)(K + s * 128 + 2 * i); const float4 qv = *(const float4*)(Q + s * 128 + 2 * i);
                    st[i] = st[i] * a + (f32x2){kv.x, kv.y} * dl; st[i + 1] = st[i + 1] * a + (f32x2){kv.z, kv.w} * dl;
                    os0 += (f32x2){qv.x, qv.y} * st[i]; os1 += (f32x2){qv.z, qv.w} * st[i + 1]; if ((i & 6) == 6) asm volatile("" ::: "memory"); }
                O[s * 128 + tid] = (os0.x + os0.y) + (os1.x + os1.y);
            }
        }
        __syncthreads();
        gdn_epilogue_chunk(p, O, b, h, t0);
    }
    __syncthreads();
}

#ifndef PREP_REP
#define PREP_REP 0
#endif
namespace gdn2 {
typedef short bf16x8 __attribute__((ext_vector_type(8)));
typedef float f32x16 __attribute__((ext_vector_type(16)));
constexpr int RK = 272, RT_ = 144;
constexpr int O_QN = 0, O_KN = 17408, O_KT = 34816, O_VT = 53248, O_L = 71680, O_RT = 88064, O_TMU = 92160, O_TMW = 101376, O_QKM = 110592, O_ST = 119808, O_G = 154624, O_END = 155648;
constexpr int O_W = O_KN, O_VNT = O_VT, O_VNTD = O_L, O_OBUF = 0;
__device__ __forceinline__ int crow(int r, int hi) { return (r & 3) + 8 * (r >> 2) + 4 * hi; }
#define CRC(i) (((i) & 3) + 8 * ((i) >> 2))
__device__ __forceinline__ unsigned short f2bf(float v) { return (unsigned short)(pk_bf16c(v, 0.f) & 0xffffu); }
template <int KS> __device__ __forceinline__ f32x16 mm32(f32x16 acc, const unsigned char* A, int lda, const unsigned char* B, int ldb, int lane) {
    const int r = lane & 31, hi = lane >> 5;
    const unsigned char* ap = A + r * lda + hi * 16; const unsigned char* bp = B + r * ldb + hi * 16;
#pragma unroll
    for (int ks = 0; ks < KS; ++ks) { const bf16x8 a = *(const bf16x8*)(ap + ks * 32); const bf16x8 b = *(const bf16x8*)(bp + ks * 32); acc = __builtin_amdgcn_mfma_f32_32x32x16_bf16(a, b, acc, 0, 0, 0); }
    return acc;
}
struct RawRegs { uint4 r[8]; };
constexpr int O_RAW = 92160, RAWROW = 784, O_CW = 144896;
__device__ __forceinline__ void stage_load(const Params& p, RawRegs& R, int b, int h, int t0) {
    const int tid = threadIdx.x; const unsigned short* GQKV = (const unsigned short*)(p.ws + WS_GQKV);
#pragma unroll
    for (int j = 0; j < 4; ++j) { const int id = tid + 512 * j; const int r = id / 24, rem = id - r * 24, part = rem >> 3, dg = rem & 7; const int tt = t0 - 3 + r;
        if (id < 1608 && tt >= 0) { const unsigned short* src = GQKV + ((size_t)b * SEQ + tt) * 1536 + part * 512 + h * 128 + dg * 16; R.r[2 * j] = *(const uint4*)src; R.r[2 * j + 1] = *(const uint4*)(src + 8); }
        else { R.r[2 * j] = make_uint4(0u, 0u, 0u, 0u); R.r[2 * j + 1] = make_uint4(0u, 0u, 0u, 0u); } }
}
__device__ __forceinline__ void stage_store_raw(unsigned char* lds, const RawRegs& R) {
    const int tid = threadIdx.x;
#pragma unroll
    for (int j = 0; j < 4; ++j) { const int id = tid + 512 * j; if (id < 1608) { const int r_ = id / 24, rem_ = id - r_ * 24; unsigned char* d_ = lds + O_RAW + r_ * RAWROW + rem_ * 32; *(uint4*)d_ = R.r[2 * j]; *(uint4*)(d_ + 16) = R.r[2 * j + 1]; } }
}
__device__ void stage_compute(const Params& p, unsigned char* lds, int b, int h, int t0) {
    const int tid = threadIdx.x; const int s = tid >> 3, dg = tid & 7;
#pragma unroll 1
    for (int part = 0; part < 3; ++part) {
        const int ch0 = part * 512 + h * 128 + dg * 16;
        float a[16];
#pragma unroll
        for (int c = 0; c < 16; ++c) a[c] = 0.f;
#pragma unroll
        for (int i = 0; i < 4; ++i) { const unsigned char* rp = lds + O_RAW + (s + i) * RAWROW + (part * 8 + dg) * 32;
            const uint4 u0 = *(const uint4*)rp, u1 = *(const uint4*)(rp + 16);
            const unsigned uu[8] = {u0.x, u0.y, u0.z, u0.w, u1.x, u1.y, u1.z, u1.w};
            const float* wp = (const float*)(lds + O_CW) + (part * 4 + i) * 128 + dg * 16;
            float wv[16];
#pragma unroll
            for (int q = 0; q < 4; ++q) { const float4 t4 = *(const float4*)(wp + 4 * q); wv[4 * q] = t4.x; wv[4 * q + 1] = t4.y; wv[4 * q + 2] = t4.z; wv[4 * q + 3] = t4.w; }
#pragma unroll
            for (int q = 0; q < 8; ++q) { a[2 * q] += wv[2 * q] * __uint_as_float(uu[q] << 16); a[2 * q + 1] += wv[2 * q + 1] * __uint_as_float(uu[q] & 0xffff0000u); } }
        float ss = 0.f;
#pragma unroll
        for (int c = 0; c < 16; ++c) { a[c] = a[c] * __builtin_amdgcn_rcpf(1.f + __builtin_amdgcn_exp2f(-1.4426950408889634f * a[c])); ss += a[c] * a[c]; }
        if (part < 2) { ss += __shfl_xor(ss, 1); ss += __shfl_xor(ss, 2); ss += __shfl_xor(ss, 4);
            float r = __builtin_amdgcn_rsqf(ss + 1e-6f); if (part == 0) r *= 0.08838834764831845f;
#pragma unroll
            for (int c = 0; c < 16; ++c) a[c] *= r; }
        if (part < 2) { unsigned char* dst = lds + (part == 0 ? O_QN : O_KN) + s * RK + dg * 32;
            *(uint4*)dst = make_uint4(pk_bf16c(a[0], a[1]), pk_bf16c(a[2], a[3]), pk_bf16c(a[4], a[5]), pk_bf16c(a[6], a[7]));
            *(uint4*)(dst + 16) = make_uint4(pk_bf16c(a[8], a[9]), pk_bf16c(a[10], a[11]), pk_bf16c(a[12], a[13]), pk_bf16c(a[14], a[15])); }
        if (part >= 1) { unsigned char* dt = lds + (part == 1 ? O_KT : O_VT) + (dg * 16) * RT_ + s * 2;
#pragma unroll
            for (int c = 0; c < 16; ++c) *(unsigned short*)(dt + c * RT_) = f2bf(a[c]); }
    }
    if (tid < 64) { float* G = (float*)(lds + O_G);
        float g = ((const float*)(p.ws + WS_GDEC))[((size_t)b * SEQ + t0 + tid) * 4 + h];
#pragma unroll
        for (int o = 1; o < 64; o <<= 1) { const float t = __shfl_up(g, o); if (tid >= o) g += t; }
        const float gl = __shfl(g, 63);
        G[tid] = g; G[64 + tid] = ((const float*)(p.ws + WS_BETA))[((size_t)b * SEQ + t0 + tid) * 4 + h]; G[128 + tid] = __expf(g); G[192 + tid] = __expf(gl - g); }
}
__device__ __forceinline__ unsigned char* prepA(const Params& p, int bh, int ch) { return (unsigned char*)p.out + (size_t)(bh * 128 + ch) * 65536; }
__device__ __forceinline__ unsigned char* prepB(const Params& p, int bh, int ch) { return p.ws + WS_PREPB + (size_t)(bh * 128 + ch) * 8704; }
#define LDSBAR() do { asm volatile("s_waitcnt lgkmcnt(0)" ::: "memory"); __builtin_amdgcn_s_barrier(); asm volatile("" ::: "memory"); } while (0)
__device__ void prep_unit(const Params& p, unsigned char* lds, int bh, int ch, RawRegs& R, bool has_next, int bh_n, int ch_n) {
    const int tid = threadIdx.x, lane = tid & 63, w = tid >> 6, hi = lane >> 5, l31 = lane & 31, b = bh >> 2, h = bh & 3;
    float* Lf = (float*)(lds + O_L); float* RTm = (float*)(lds + O_RT); const float* GC = (const float*)(lds + O_G); const float* BE = GC + 64; const float* EG = GC + 128;
    const int t0 = ch * 64;
    unsigned char* ga = prepA(p, bh, ch); unsigned char* gb = prepB(p, bh, ch);
    LDSBAR();
    stage_store_raw(lds, R);
    if (has_next) stage_load(p, R, bh_n >> 2, bh_n & 3, ch_n * 64);
    LDSBAR();
    stage_compute(p, lds, b, h, t0);
    LDSBAR();
    if (PREP_REP & 1) { stage_compute(p, lds, b, h, t0); LDSBAR(); }
#pragma unroll
    for (int i = 0; i < 2; ++i) { const int pc = tid + i * 512;
        *(uint4*)(ga + 32768 + pc * 16) = *(const uint4*)(lds + O_QN + (pc >> 4) * RK + (pc & 15) * 16);
        *(uint4*)(ga + 49152 + pc * 16) = *(const uint4*)(lds + O_KT + (pc >> 3) * RT_ + (pc & 7) * 16); }
    if (tid < 32) *(uint4*)(gb + 8192 + tid * 16) = *(const uint4*)(lds + O_G + 512 + tid * 16);
#pragma unroll 1
    for (int rep2 = 0; rep2 < ((PREP_REP & 16) ? 2 : 1); ++rep2) {
#pragma unroll 1
    for (int rep = 0; rep < ((PREP_REP & 2) ? 2 : 1); ++rep) {
    { const int tr = (w >> 1) & 1, tc = w & 1; const bool isQ = w >= 4;
      f32x16 acc;
#pragma unroll
      for (int i = 0; i < 16; ++i) acc[i] = 0.f;
      acc = mm32<8>(acc, lds + (isQ ? O_QN : O_KN) + tr * 32 * RK, RK, lds + O_KN + tc * 32 * RK, RK, lane);
      const int s = tc * 32 + l31; const float gs = GC[s]; const int cb = tr * 32 + 4 * hi;
      const float* gcb = GC + cb; const float* beb = BE + cb; float* lfb = Lf + cb * 64 + s; unsigned char* qkb = lds + O_QKM + cb * RT_ + s * 2;
#pragma unroll
      for (int i = 0; i < 16; ++i) { const int c = cb + CRC(i); const float dec = __expf(fminf(gcb[CRC(i)] - gs, 0.f));
          if (!isQ) lfb[CRC(i) * 64] = (c > s) ? beb[CRC(i)] * acc[i] * dec : 0.f;
          else *(unsigned short*)(qkb + CRC(i) * RT_) = f2bf((c >= s) ? acc[i] * dec : 0.f); } }
    LDSBAR();
    }
    *(uint4*)(gb + tid * 16) = *(const uint4*)(lds + O_QKM + (tid >> 3) * RT_ + (tid & 7) * 16);
    if (w == 0) { const int g4 = lane >> 4, j = lane & 15; float t[16];
        const float* Lb = Lf + (16 * g4) * 64 + 16 * g4;
#pragma unroll
        for (int i = 0; i < 16; ++i) { float a = (i == j) ? 1.f : 0.f;
#pragma unroll
            for (int k = 0; k < i; ++k) a -= Lb[i * 64 + k] * t[k];
            t[i] = a; if ((i & 3) == 3) asm volatile("" ::: "memory"); }
        asm volatile("s_waitcnt lgkmcnt(0)" ::: "memory");
#pragma unroll
        for (int i = 0; i < 16; ++i) Lf[(16 * g4 + i) * 64 + 16 * g4 + j] = t[i]; }
    LDSBAR();
#pragma unroll 1
    for (int I = 1; I < 4; ++I) { const int c = tid & 63, r = tid >> 6, n = 16 * I;
        if (c < n) { float a0 = 0.f, a1 = 0.f;
#pragma unroll 8
            for (int k = 0; k < n; ++k) { const float tm = Lf[k * 64 + c]; a0 -= Lf[(n + r) * 64 + k] * tm; a1 -= Lf[(n + r + 8) * 64 + k] * tm; }
            RTm[r * 64 + c] = a0; RTm[(r + 8) * 64 + c] = a1; }
        LDSBAR();
        if (c < n) { float b0 = 0.f, b1 = 0.f;
#pragma unroll
            for (int k = 0; k < 16; ++k) { const float rk = RTm[k * 64 + c]; b0 += Lf[(n + r) * 64 + n + k] * rk; b1 += Lf[(n + r + 8) * 64 + n + k] * rk; }
            Lf[(n + r) * 64 + c] = b0; Lf[(n + r + 8) * 64 + c] = b1; }
        LDSBAR(); }
    }
#pragma unroll 1
    for (int rep4 = 0; rep4 < ((PREP_REP & 4) ? 2 : 1); ++rep4) {
    LDSBAR();
    { const int c = tid >> 3, s0 = (tid & 7) * 8; float u[8], ww[8];
#pragma unroll
      for (int q = 0; q < 8; ++q) { const float t = Lf[c * 64 + s0 + q] * BE[s0 + q]; u[q] = t; ww[q] = t * EG[s0 + q]; }
      *(uint4*)(lds + O_TMU + c * RT_ + s0 * 2) = make_uint4(pk_bf16c(u[0], u[1]), pk_bf16c(u[2], u[3]), pk_bf16c(u[4], u[5]), pk_bf16c(u[6], u[7]));
      *(uint4*)(lds + O_TMW + c * RT_ + s0 * 2) = make_uint4(pk_bf16c(ww[0], ww[1]), pk_bf16c(ww[2], ww[3]), pk_bf16c(ww[4], ww[5]), pk_bf16c(ww[6], ww[7])); }
    LDSBAR();
    { f32x16 z;
#pragma unroll
      for (int i = 0; i < 16; ++i) z[i] = 0.f;
      const f32x16 ut = mm32<4>(z, lds + O_VT + (w >> 1) * 32 * RT_, RT_, lds + O_TMU + (w & 1) * 32 * RT_, RT_, lane);
      *(uint4*)(ga + tid * 32) = make_uint4(pk_bf16c(ut[0], ut[1]), pk_bf16c(ut[2], ut[3]), pk_bf16c(ut[4], ut[5]), pk_bf16c(ut[6], ut[7]));
      *(uint4*)(ga + tid * 32 + 16) = make_uint4(pk_bf16c(ut[8], ut[9]), pk_bf16c(ut[10], ut[11]), pk_bf16c(ut[12], ut[13]), pk_bf16c(ut[14], ut[15]));
      const f32x16 wa = mm32<4>(z, lds + O_TMW + (w >> 2) * 32 * RT_, RT_, lds + O_KT + (w & 3) * 32 * RT_, RT_, lane);
      unsigned char* wb = lds + O_W + ((w >> 2) * 32 + 4 * hi) * RK + ((w & 3) * 32 + l31) * 2;
#pragma unroll
      for (int i = 0; i < 16; ++i) *(unsigned short*)(wb + CRC(i) * RK) = f2bf(wa[i]); }
    LDSBAR();
#pragma unroll
    for (int i = 0; i < 2; ++i) { const int pc = tid + i * 512; *(uint4*)(ga + 16384 + pc * 16) = *(const uint4*)(lds + O_W + (pc >> 4) * RK + (pc & 15) * 16); }
    }
}
__device__ __forceinline__ uint4 ldc16(const unsigned char* p) {
    const unsigned long long a = __hip_atomic_load((const unsigned long long*)p, __ATOMIC_RELAXED, __HIP_MEMORY_SCOPE_AGENT);
    const unsigned long long b = __hip_atomic_load((const unsigned long long*)p + 1, __ATOMIC_RELAXED, __HIP_MEMORY_SCOPE_AGENT);
    return make_uint4((unsigned)a, (unsigned)(a >> 32), (unsigned)b, (unsigned)(b >> 32)); }
constexpr int O_OB2 = 90112;
__device__ __forceinline__ void scan_epilogue(const Params& p, const unsigned char* lds, int b, int h, int t0, uint4 z0, uint4 z1, const float (&gg)[16]) {
    const int tid = threadIdx.x; const int s = tid >> 3, dg = tid & 7;
    const uint4 q0 = *(const uint4*)(lds + O_OB2 + s * RK + dg * 32), q1 = *(const uint4*)(lds + O_OB2 + s * RK + dg * 32 + 16);
    const unsigned qq[8] = {q0.x, q0.y, q0.z, q0.w, q1.x, q1.y, q1.z, q1.w};
    float o[16]; float ss = 0.f;
#pragma unroll
    for (int q = 0; q < 8; ++q) { o[2 * q] = __uint_as_float(qq[q] << 16); o[2 * q + 1] = __uint_as_float(qq[q] & 0xffff0000u); }
#pragma unroll
    for (int c = 0; c < 16; ++c) ss += o[c] * o[c];
    ss += __shfl_xor(ss, 1); ss += __shfl_xor(ss, 2); ss += __shfl_xor(ss, 4);
    const float rstd = __builtin_amdgcn_rsqf(ss * (1.0f / 128.0f) + 1e-6f);
    const size_t tok = (size_t)b * SEQ + t0 + s;
    const unsigned zz[8] = {z0.x, z0.y, z0.z, z0.w, z1.x, z1.y, z1.z, z1.w};
    unsigned ow[8];
#pragma unroll
    for (int q = 0; q < 8; ++q) { const float za = __uint_as_float(zz[q] << 16), zb = __uint_as_float(zz[q] & 0xffff0000u);
        const float sa = za * __builtin_amdgcn_rcpf(1.f + __builtin_amdgcn_exp2f(-1.4426950408889634f * za)), sb = zb * __builtin_amdgcn_rcpf(1.f + __builtin_amdgcn_exp2f(-1.4426950408889634f * zb));
        const float va = o[2 * q] * rstd * gg[2 * q] * sa, vb = o[2 * q + 1] * rstd * gg[2 * q + 1] * sb;
        ow[q] = pk_bf16(va, vb); }
    unsigned short* dst = (unsigned short*)(p.ws + WS_HB) + tok * 1024 + h * 128 + dg * 16;
    *(uint4*)dst = make_uint4(ow[0], ow[1], ow[2], ow[3]); *(uint4*)(dst + 8) = make_uint4(ow[4], ow[5], ow[6], ow[7]);
}
__device__ void scan_unit(const Params& p, unsigned char* lds, int bh) {
    const int tid = threadIdx.x, lane = tid & 63, w = tid >> 6, hi = lane >> 5, l31 = lane & 31, b = bh >> 2, h = bh & 3;
    const float* GC = (const float*)(lds + O_G); const float* EG = GC + 128; const float* DL = GC + 192;
    f32x16 Sacc[2];
#pragma unroll
    for (int i = 0; i < 16; ++i) { Sacc[0][i] = 0.f; Sacc[1][i] = 0.f; }
    for (int i = tid; i < 34816 / 16; i += 512) ((uint4*)(lds + O_ST))[i] = make_uint4(0u, 0u, 0u, 0u);
    uint4 rU0, rU1, rW0, rW1, rQ0, rQ1, rK0, rK1, rM, rG = make_uint4(0u, 0u, 0u, 0u), rZ0, rZ1;
    const int es = tid >> 3, edg = tid & 7;
#define SCAN_LOAD(chn) do { const unsigned char* ga_ = prepA(p, bh, (chn)); const unsigned char* gb_ = prepB(p, bh, (chn));                          \
        rU0 = *(const uint4*)(ga_ + tid * 32); rU1 = *(const uint4*)(ga_ + tid * 32 + 16);                                                           \
        rW0 = *(const uint4*)(ga_ + 16384 + tid * 16); rW1 = *(const uint4*)(ga_ + 16384 + (tid + 512) * 16);                                        \
        rQ0 = *(const uint4*)(ga_ + 32768 + tid * 16); rQ1 = *(const uint4*)(ga_ + 32768 + (tid + 512) * 16);                                        \
        rK0 = *(const uint4*)(ga_ + 49152 + tid * 16); rK1 = *(const uint4*)(ga_ + 49152 + (tid + 512) * 16);                                        \
        rM = *(const uint4*)(gb_ + tid * 16); if (tid < 32) rG = *(const uint4*)(gb_ + 8192 + tid * 16);                                             \
        { const unsigned short* zp_ = (const unsigned short*)(p.ws + WS_ZG) + ((size_t)b * SEQ + (chn) * 64 + es) * 3072 + h * 128 + edg * 16;       \
          rZ0 = *(const uint4*)zp_; rZ1 = *(const uint4*)(zp_ + 8); } } while (0)
    f32x16 ut; uint4 zc0, zc1, zp0 = make_uint4(0u, 0u, 0u, 0u), zp1 = zp0;
    float gg[16];
#pragma unroll
    for (int q = 0; q < 16; ++q) gg[q] = p.g_gdn_out[edg * 16 + q];
#define SCAN_FILL() do { const int p0_ = tid, p1_ = tid + 512;                                                                                       \
        { const unsigned uu_[8] = {rU0.x, rU0.y, rU0.z, rU0.w, rU1.x, rU1.y, rU1.z, rU1.w};                                                          \
          _Pragma("unroll") for (int q = 0; q < 8; ++q) { ut[2 * q] = __uint_as_float(uu_[q] << 16); ut[2 * q + 1] = __uint_as_float(uu_[q] & 0xffff0000u); } } \
        *(uint4*)(lds + O_W + (p0_ >> 4) * RK + (p0_ & 15) * 16) = rW0; *(uint4*)(lds + O_W + (p1_ >> 4) * RK + (p1_ & 15) * 16) = rW1;              \
        *(uint4*)(lds + O_QN + (p0_ >> 4) * RK + (p0_ & 15) * 16) = rQ0; *(uint4*)(lds + O_QN + (p1_ >> 4) * RK + (p1_ & 15) * 16) = rQ1;            \
        *(uint4*)(lds + O_KT + (p0_ >> 3) * RT_ + (p0_ & 7) * 16) = rK0; *(uint4*)(lds + O_KT + (p1_ >> 3) * RT_ + (p1_ & 7) * 16) = rK1;            \
        *(uint4*)(lds + O_QKM + (tid >> 3) * RT_ + (tid & 7) * 16) = rM;                                                                             \
        if (tid < 32) *(uint4*)(lds + O_G + 512 + tid * 16) = rG;                                                                                    \
        zc0 = rZ0; zc1 = rZ1; } while (0)
    SCAN_LOAD(0);
    SCAN_FILL();
    SCAN_LOAD(1);
    LDSBAR();
#pragma unroll 1
    for (int ch = 0; ch < SEQ / 64; ++ch) {
        if (ch > 0) scan_epilogue(p, lds, b, h, (ch - 1) * 64, zp0, zp1, gg);
        f32x16 oacc;
        { f32x16 z;
#pragma unroll
          for (int i = 0; i < 16; ++i) z[i] = 0.f;
          const f32x16 acc = mm32<8>(z, lds + O_ST + (w >> 1) * 32 * RK, RK, lds + O_W + (w & 1) * 32 * RK, RK, lane);
          const int c = (w & 1) * 32 + l31; const float dl = DL[c]; unsigned char* vb_ = lds + O_VNT + ((w >> 1) * 32 + 4 * hi) * RT_ + c * 2;
#pragma unroll
          for (int i = 0; i < 16; ++i) { const float vn = ut[i] - acc[i];
              *(unsigned short*)(vb_ + CRC(i) * RT_) = f2bf(vn); *(unsigned short*)(vb_ + (O_VNTD - O_VNT) + CRC(i) * RT_) = f2bf(vn * dl); }
          oacc = mm32<8>(z, lds + O_QN + (w >> 2) * 32 * RK, RK, lds + O_ST + (w & 3) * 32 * RK, RK, lane);
          { const float* egb = EG + (w >> 2) * 32 + 4 * hi;
#pragma unroll
            for (int i = 0; i < 16; ++i) oacc[i] *= egb[CRC(i)]; }
          const float gam = EG[63];
#pragma unroll
          for (int j = 0; j < 2; ++j)
#pragma unroll
              for (int i = 0; i < 16; ++i) Sacc[j][i] *= gam; }
        LDSBAR();
        oacc = mm32<4>(oacc, lds + O_QKM + (w >> 2) * 32 * RT_, RT_, lds + O_VNT + (w & 3) * 32 * RT_, RT_, lane);
#pragma unroll
        for (int j = 0; j < 2; ++j) Sacc[j] = mm32<4>(Sacc[j], lds + O_VNTD + (w >> 1) * 32 * RT_, RT_, lds + O_KT + ((w & 1) * 2 + j) * 32 * RT_, RT_, lane);
        LDSBAR();
#pragma unroll
        for (int j = 0; j < 2; ++j) { unsigned char* sb_ = lds + O_ST + ((w >> 1) * 32 + 4 * hi) * RK + (((w & 1) * 2 + j) * 32 + l31) * 2;
#pragma unroll
            for (int i = 0; i < 16; ++i) *(unsigned short*)(sb_ + CRC(i) * RK) = f2bf(Sacc[j][i]); }
        { unsigned char* ob_ = lds + O_OB2 + ((w >> 2) * 32 + 4 * hi) * RK + ((w & 3) * 32 + l31) * 2;
#pragma unroll
          for (int i = 0; i < 16; ++i) *(unsigned short*)(ob_ + CRC(i) * RK) = f2bf(oacc[i]); }
        zp0 = zc0; zp1 = zc1;
        if (ch + 1 < SEQ / 64) { SCAN_FILL(); if (ch + 2 < SEQ / 64) SCAN_LOAD(ch + 2); }
        LDSBAR();
    }
    scan_epilogue(p, lds, b, h, (SEQ / 64 - 1) * 64, zp0, zp1, gg);
    __syncthreads();
#undef SCAN_LOAD
#undef SCAN_FILL
}
}

__device__ __forceinline__ void attn_phase(const Params& p, unsigned char* lds8, int rep) {
    using namespace fox;
    typedef BlockRef<bf16, bf16> Ref;
    char* lds = (char*)lds8;
    volatile int* slot = (volatile int*)(lds + SLOT_OFF);
    unsigned* ctr = (unsigned*)(p.ws + WS_CTRL) + rep;
    const int total = NBATCH * NHEAD * (SEQ / QB);
    const bf16* FQ = (const bf16*)(p.ws + WS_FQKV); const bf16* FK = FQ + (size_t)MTOK * 512; const bf16* FV = FK + (size_t)MTOK * 512;
    auto mkref = [&](int L) { Ref r; const int qb = (SEQ / QB - 1) - (L >> 5), bh = L & 31, b = bh >> 2, h = bh & 3;
        r.Q = FQ + ((size_t)bh * SEQ + (size_t)qb * QB) * D; r.K = FK + (size_t)bh * SEQ * D; r.V = FV + (size_t)bh * SEQ * D;
        r.KB = (const float*)(p.ws + WS_KBIAS) + (size_t)bh * SEQ;
        r.O = (bf16*)(p.ws + WS_HB) + ((size_t)b * SEQ + (size_t)qb * QB) * OSTR + 512 + h * 128;
        r.Z = (const unsigned short*)(p.ws + WS_ZG) + ((size_t)b * SEQ + (size_t)qb * QB) * ZSTR + 512 + h * 128;
        r.P0 = qb * QB; r.JLO = ((const int*)(p.ws + WS_JLO))[bh * 32 + qb]; return r; };
    int it = 0;
    __syncthreads();
    if (threadIdx.x == 0) slot[0] = (int)atomicAdd(ctr, 1u);
    __syncthreads();
    int L = __builtin_amdgcn_readfirstlane(slot[0]);
    if (L >= total) return;
    Ref cur = mkref(L);
    Seam<bf16> S;
    causal_swa_prime<bf16, bf16>(cur, 1 << 20, lds, S);
    for (;;) {
        ++it;
        if (threadIdx.x == 0) slot[it & 1] = (int)atomicAdd(ctr, 1u);
        __syncthreads();
        const int Ln = __builtin_amdgcn_readfirstlane(slot[it & 1]);
        const bool last = Ln >= total;
        const Ref nxt = last ? cur : mkref(Ln);
        causal_swa_block<bf16, bf16>(cur, nxt, SEQ, 1 << 20, lds, S);
        if (last) break;
        cur = nxt;
    }
    __syncthreads();
}

__device__ __forceinline__ void run_p2(const Params& p, unsigned char* lds) {
    phase_cumsum(p, lds);
    __syncthreads();
    pg8::Gemm g{(const pg8::bf16_t*)(p.ws + WS_HB), (const pg8::bf16_t*)(p.ws + WS_WIN_T), MTOK, NPROJ, 1024, 1024, 1024};
    pg8::StaticOrder S; S.init(MTOK, NPROJ, gridDim.x, blockIdx.x);
    pg8::EpiProj E{(pg8::bf16_t*)(p.ws + WS_GQKV), (pg8::bf16_t*)(p.ws + WS_FQKV), (pg8::bf16_t*)(p.ws + WS_ZG), p.g_q_fox, p.g_k_fox, (PG8_LAS float*)((PG8_LAS unsigned char*)lds + GEMM_X_OFF)};
    pg8::gemm_phase<pg8::EpiProj, pg8::StaticOrder, true, true>((PG8_LAS unsigned char*)lds, g, S, E);
}
__device__ __forceinline__ void run_p3a(const Params& p, unsigned char* lds) {
    { const int h0 = blockIdx.x & 3; float* cw = (float*)(lds + gdn2::O_CW);
      for (int i = threadIdx.x; i < 1536; i += 512) { const int pt = i >> 7, d = i & 127, part = pt >> 2, tap = pt & 3; cw[i] = p.conv_w[tap * 1536 + part * 512 + h0 * 128 + d]; } }
    gdn2::RawRegs R; { const int L0 = blockIdx.x; if (L0 < 4096) gdn2::stage_load(p, R, (L0 & 31) >> 2, L0 & 3, (L0 >> 5) * 64); }
#pragma unroll 1
    for (int L = blockIdx.x; L < 4096; L += gridDim.x) { const int Ln = L + gridDim.x; gdn2::prep_unit(p, lds, L & 31, L >> 5, R, Ln < 4096, Ln & 31, Ln >> 5); }
    __syncthreads();
}
__device__ __forceinline__ void run_p3(const Params& p, unsigned char* lds, int rep) {
    if (PH_MASK & 64) { if (blockIdx.x < 32) { gdn2::scan_unit(p, lds, blockIdx.x); if (PREP_REP & 8) gdn2::scan_unit(p, lds, blockIdx.x); } }
    if (PH_MASK & 8) attn_phase(p, lds, rep);
}
__device__ __forceinline__ void run_p4(const Params& p, unsigned char* lds) {
    pg8::Gemm g{(const pg8::bf16_t*)(p.ws + WS_HB), (const pg8::bf16_t*)(p.ws + WS_WO2_T), MTOK, 1024, 1024, 1024, 1024};
    pg8::StaticOrder S; S.init(MTOK, 1024, gridDim.x, blockIdx.x);
    pg8::EpiMerge E{(pg8::bf16_t*)(p.ws + WS_FQKV), (const pg8::bf16_t*)(p.ws + WS_ZG) + 1024};
    pg8::gemm_phase<pg8::EpiMerge, pg8::StaticOrder, true, true>((PG8_LAS unsigned char*)lds, g, S, E);
}
__device__ __forceinline__ void run_p5(const Params& p, unsigned char* lds) {
    pg8::Gemm g{(const pg8::bf16_t*)(p.ws + WS_FQKV), (const pg8::bf16_t*)(p.ws + WS_WOUT2_T), MTOK, 1024, 1024, 1024, 2048};
    pg8::StaticOrder S; S.init(MTOK, 1024, gridDim.x, blockIdx.x);
    pg8::EpiOut E{p.x, p.out, (const float*)(p.ws + WS_MOD)};
    pg8::gemm_phase<pg8::EpiOut, pg8::StaticOrder, true, true>((PG8_LAS unsigned char*)lds, g, S, E);
}

__global__ void __launch_bounds__(512, 2) fwd_kernel(Params p, int ph_lo, int ph_hi) {
    extern __shared__ __attribute__((aligned(16))) unsigned char lds[];
    cg::grid_group grid = cg::this_grid();
#define GSYNC() do { grid.sync(); } while (0)
#define IN(ph) (ph_lo <= (ph) && (ph) < ph_hi)
#define SEAM(ph) do { if (IN(ph) && (ph) + 1 < ph_hi) GSYNC(); } while (0)
    if (IN(0)) { if (PH_MASK & 1) phase_prologue(p, lds); }
#if REPEAT_PH == 0
    GSYNC(); phase_prologue(p, lds);
#endif
    SEAM(0);
    if (IN(1)) { if (PH_MASK & 2) phase_prepass(p, lds); }
#if REPEAT_PH == 1
    GSYNC(); phase_prepass(p, lds);
#endif
    SEAM(1);
    if (IN(2) && (PH_MASK & 4)) run_p2(p, lds);
#if REPEAT_PH == 2
    GSYNC(); run_p2(p, lds);
#endif
    SEAM(2);
    if (IN(3)) { run_p3a(p, lds); GSYNC(); run_p3(p, lds, 0); }
#if REPEAT_PH == 3
    GSYNC(); run_p3(p, lds, 1);
#endif
#if REPEAT_PH == 6
    GSYNC(); run_p3a(p, lds);
#endif
    SEAM(3);
    if (IN(4) && (PH_MASK & 16)) run_p4(p, lds);
#if REPEAT_PH == 4
    GSYNC(); run_p4(p, lds);
#endif
    SEAM(4);
    if (IN(5) && (PH_MASK & 32)) run_p5(p, lds);
#if REPEAT_PH == 5
    GSYNC(); run_p5(p, lds);
#endif
}

extern "C" void kernel_launch(void* const* d_in, const int* in_sizes, int n_in, void* d_out, int out_size, void* d_ws, size_t ws_size, hipStream_t stream) {
    static int grid_blocks = 0;
    if (grid_blocks == 0) {
        if (n_in != 16 || out_size != MTOK * DM || ws_size < WS_END) { fprintf(stderr, "kernel_launch: unexpected shapes (n_in %d out %d ws %zu need %zu)\n", n_in, out_size, ws_size, (size_t)WS_END); grid_blocks = -1; return; }
        int dev = 0, cus = 0, per_cu = 0;
        (void)hipGetDevice(&dev); (void)hipDeviceGetAttribute(&cus, hipDeviceAttributeMultiprocessorCount, dev);
        if (hipFuncSetAttribute((const void*)fwd_kernel, hipFuncAttributeMaxDynamicSharedMemorySize, LDS_TOTAL) != hipSuccess) fprintf(stderr, "kernel_launch: hipFuncSetAttribute failed\n");
        if (hipOccupancyMaxActiveBlocksPerMultiprocessor(&per_cu, (const void*)fwd_kernel, 512, LDS_TOTAL) != hipSuccess || per_cu < 1) { fprintf(stderr, "kernel_launch: occupancy query says %d\n", per_cu); per_cu = 1; }
        (void)hipGetLastError();
        grid_blocks = cus - cus % 32;
        if (grid_blocks <= 0) grid_blocks = 256;
    }
    if (grid_blocks < 0) return;
    Params p{};
    p.x = (const float*)d_in[0]; p.c = (const float*)d_in[1]; p.w_ada = (const float*)d_in[2]; p.b_ada = (const float*)d_in[3]; p.g_norm = (const float*)d_in[4]; p.w_in = (const float*)d_in[5];
    p.conv_w = (const float*)d_in[6]; p.A_log = (const float*)d_in[7]; p.dt_bias = (const float*)d_in[8]; p.g_gdn_out = (const float*)d_in[9]; p.g_q_fox = (const float*)d_in[10]; p.g_k_fox = (const float*)d_in[11];
    p.b_f = (const float*)d_in[12]; p.w_o_gdn = (const float*)d_in[13]; p.w_o_fox = (const float*)d_in[14]; p.w_out = (const float*)d_in[15];
    p.out = (float*)d_out; p.ws = (unsigned char*)d_ws;
#ifdef MULTI_LAUNCH
    for (int ph = 0; ph < 6; ++ph) { int lo = ph, hi = ph + 1; void* args[] = {&p, &lo, &hi};
        hipError_t e = hipLaunchCooperativeKernel((const void*)fwd_kernel, dim3(grid_blocks), dim3(512), args, LDS_TOTAL, stream);
        if (e != hipSuccess) fprintf(stderr, "launch %d failed: %s\n", ph, hipGetErrorString(e)); }
#else
    int lo = 0, hi = 6; void* args[] = {&p, &lo, &hi};
    hipError_t e = hipLaunchCooperativeKernel((const void*)fwd_kernel, dim3(grid_blocks), dim3(512), args, LDS_TOTAL, stream);
    if (e != hipSuccess) fprintf(stderr, "cooperative launch failed: %s (grid %d)\n", hipGetErrorString(e), grid_blocks);
#endif
}
```
